# Optimizing an MI355X kernel written in HIP

```python
import math
import jax
import jax.numpy as jnp
from jax import lax
import numpy as np

D_MODEL = 1024
BATCH = 16
SEQ = 2048
DEPTH = 4

CHUNK = 64
N_MIXERS = 3
S5_GROUP = 16
S5_GROUPS = D_MODEL // S5_GROUP
S5_STATE = 64
S5_DT_MIN = 0.001
S5_DT_MAX = 0.1
DA_HEAD_DIM = 64
DA_HEADS = D_MODEL // (2 * DA_HEAD_DIM)
ROPE_THETA = 10000.0
Q_BLOCK = 128
POOL_WINDOWS = (2, 4, 8, 16)
POOL_GROUP = D_MODEL // len(POOL_WINDOWS)
D_FF = 4 * D_MODEL
EPS = 1e-6
N_S5 = (DEPTH + 2) // 3
N_DA = (DEPTH + 1) // 3
N_POOL = DEPTH // 3

kernel_name = 'hybrid_s5_diffattn_pool_stream_encoder'


def rmsnorm(x, g):
    xf = x.astype(jnp.float32)
    y = xf * lax.rsqrt(jnp.mean(xf * xf, axis=-1, keepdims=True) + EPS)
    return y * g.astype(jnp.float32)


def cmul(ar, ai, br, bi):
    return ar * br - ai * bi, ar * bi + ai * br


def s5_mixer(h, w_in, lam_re, lam_im, log_step, b_re, b_im, c_re, c_im, d_skip, w_gate, w_out):
    bsz, seq, _ = h.shape
    f32 = jnp.float32
    u = (h @ w_in).astype(f32)
    lr = jnp.minimum(lam_re.astype(f32), -1e-4)
    li = lam_im.astype(f32)
    dt = jnp.exp(log_step.astype(f32))[:, None]
    mag = jnp.exp(lr * dt)
    abar_re = mag * jnp.cos(li * dt)
    abar_im = mag * jnp.sin(li * dt)
    den = lr * lr + li * li
    nr = abar_re - 1.0
    f_re = (nr * lr + abar_im * li) / den
    f_im = (abar_im * lr - nr * li) / den
    bbar_re, bbar_im = cmul(f_re[..., None], f_im[..., None], b_re, b_im)
    n_chunks = seq // CHUNK
    ug = u.reshape(bsz, n_chunks, CHUNK, S5_GROUPS, S5_GROUP)
    ug = jnp.moveaxis(ug, 1, 0)
    a_re = jnp.broadcast_to(abar_re, (bsz, CHUNK, S5_GROUPS, S5_STATE))
    a_im = jnp.broadcast_to(abar_im, (bsz, CHUNK, S5_GROUPS, S5_STATE))

    def combine(e1, e2):
        a1r, a1i, b1r, b1i = e1
        a2r, a2i, b2r, b2i = e2
        ar, ai = cmul(a2r, a2i, a1r, a1i)
        br, bi = cmul(a2r, a2i, b1r, b1i)
        return ar, ai, br + b2r, bi + b2i

    def chunk_step(carry, u_c):
        h_re, h_im = carry
        bu_re = jnp.einsum('btgh,gph->btgp', u_c, bbar_re)
        bu_im = jnp.einsum('btgh,gph->btgp', u_c, bbar_im)
        pw_re, pw_im, xr, xi = lax.associative_scan(combine, (a_re, a_im, bu_re, bu_im), axis=1)
        cr, ci = cmul(pw_re, pw_im, h_re[:, None], h_im[:, None])
        xr = xr + cr
        xi = xi + ci
        y = jnp.einsum('btgp,ghp->btgh', xr, c_re) - jnp.einsum('btgp,ghp->btgh', xi, c_im)
        return (xr[:, -1], xi[:, -1]), y

    h0 = jnp.zeros((bsz, S5_GROUPS, S5_STATE), f32)
    _, ys = lax.scan(chunk_step, (h0, h0), ug)
    y = jnp.moveaxis(ys, 0, 1).reshape(bsz, seq, D_MODEL) + d_skip * u
    z = jax.nn.gelu(y)
    z = z * jax.nn.sigmoid(z @ w_gate)
    return z @ w_out


def apply_rope(t, cos, sin):
    half = t.shape[-1] // 2
    t1, t2 = t[..., :half], t[..., half:]
    c = cos[None, :, None, None, :]
    s = sin[None, :, None, None, :]
    return jnp.concatenate([t1 * c - t2 * s, t2 * c + t1 * s], axis=-1)


def diff_attn_mixer(h, w_qkv, lq1, lk1, lq2, lk2, subln, w_o, lam_init):
    bsz, seq, _ = h.shape
    f32 = jnp.float32
    qkv = h @ w_qkv
    q, k, v = jnp.split(qkv, 3, axis=-1)
    q = q.reshape(bsz, seq, DA_HEADS, 2, DA_HEAD_DIM).astype(f32)
    k = k.reshape(bsz, seq, DA_HEADS, 2, DA_HEAD_DIM).astype(f32)
    v = v.reshape(bsz, seq, DA_HEADS, 2 * DA_HEAD_DIM).astype(f32)
    pos = jnp.arange(seq, dtype=f32)
    inv_freq = ROPE_THETA ** (-jnp.arange(0, DA_HEAD_DIM, 2, dtype=f32) / DA_HEAD_DIM)
    ang = pos[:, None] * inv_freq[None, :]
    cos, sin = jnp.cos(ang), jnp.sin(ang)
    q = apply_rope(q, cos, sin) * (DA_HEAD_DIM ** -0.5)
    k = apply_rope(k, cos, sin)
    lam = (jnp.exp(jnp.sum(lq1.astype(f32) * lk1.astype(f32)))
           - jnp.exp(jnp.sum(lq2.astype(f32) * lk2.astype(f32))) + lam_init)
    n_blk = seq // Q_BLOCK
    qb = jnp.moveaxis(q.reshape(bsz, n_blk, Q_BLOCK, DA_HEADS, 2, DA_HEAD_DIM), 1, 0)
    k_chunk = jnp.arange(seq) // CHUNK

    def block(args):
        q_blk, j = args
        s = jnp.einsum('bqhmd,bkhmd->bhmqk', q_blk, k)
        q_chunk = (j * Q_BLOCK + jnp.arange(Q_BLOCK)) // CHUNK
        mask = k_chunk[None, :] <= q_chunk[:, None]
        p = jax.nn.softmax(jnp.where(mask, s, -jnp.inf), axis=-1)
        a = p[:, :, 0] - lam * p[:, :, 1]
        return jnp.einsum('bhqk,bkhe->bqhe', a, v)

    o = lax.map(block, (qb, jnp.arange(n_blk)))
    o = jnp.moveaxis(o, 0, 1).reshape(bsz, seq, DA_HEADS, 2 * DA_HEAD_DIM)
    o = o * lax.rsqrt(jnp.mean(o * o, axis=-1, keepdims=True) + EPS) * subln.astype(f32) * (1.0 - lam_init)
    return o.reshape(bsz, seq, D_MODEL) @ w_o


def pool_mixer(h, w_pool, scale):
    bsz, seq, _ = h.shape
    cs = jnp.cumsum(h, axis=1)
    t = jnp.arange(1, seq + 1, dtype=jnp.float32)[None, :, None]
    outs = []
    for g, w in enumerate(POOL_WINDOWS):
        sl = slice(g * POOL_GROUP, (g + 1) * POOL_GROUP)
        c = cs[..., sl]
        prev = jnp.pad(c, ((0, 0), (w, 0), (0, 0)))[:, :seq]
        mean = (c - prev) / jnp.minimum(t, float(w))
        outs.append(mean - h[..., sl])
    p = jnp.stack(outs, axis=2)
    y = jnp.einsum('bsgc,gcd->bsgd', p, w_pool).reshape(bsz, seq, D_MODEL)
    return y * scale


def sqrelu_mlp(h, w1, w2):
    return jnp.square(jax.nn.relu(h @ w1)) @ w2


def setup_inputs(seed: int = 0) -> dict:
    key = jax.random.key(seed)
    ks = iter(jax.random.split(key, 32))
    f32 = jnp.float32

    def nrm(shape, scale):
        return jax.random.normal(next(ks), shape, f32) * scale

    D, G, P, H = D_MODEL, S5_GROUPS, S5_STATE, S5_GROUP
    x = nrm((BATCH, SEQ, D), 1.0)
    norm_mix = 1.0 + nrm((DEPTH, D), 0.02)
    norm_mlp = 1.0 + nrm((DEPTH, D), 0.02)
    norm_final = 1.0 + nrm((D,), 0.02)
    s5_w_in = nrm((N_S5, D, D), D ** -0.5)
    s5_lam_re = -0.5 + nrm((N_S5, G, P), 0.01)
    s5_lam_im = math.pi * jnp.arange(P, dtype=f32) + nrm((N_S5, G, P), 0.01)
    s5_log_step = jax.random.uniform(next(ks), (N_S5, G), f32, math.log(S5_DT_MIN), math.log(S5_DT_MAX))
    s5_b_re = nrm((N_S5, G, P, H), (2 * H) ** -0.5)
    s5_b_im = nrm((N_S5, G, P, H), (2 * H) ** -0.5)
    s5_c_re = nrm((N_S5, G, H, P), 0.5)
    s5_c_im = nrm((N_S5, G, H, P), 0.5)
    s5_d = nrm((N_S5, D), 1.0)
    s5_w_gate = nrm((N_S5, D, D), D ** -0.5)
    s5_w_out = nrm((N_S5, D, D), D ** -0.5)
    da_w_qkv = nrm((N_DA, D, 3 * D), D ** -0.5)
    da_lam_q1 = nrm((N_DA, DA_HEAD_DIM), 0.1)
    da_lam_k1 = nrm((N_DA, DA_HEAD_DIM), 0.1)
    da_lam_q2 = nrm((N_DA, DA_HEAD_DIM), 0.1)
    da_lam_k2 = nrm((N_DA, DA_HEAD_DIM), 0.1)
    da_subln = 1.0 + nrm((N_DA, 2 * DA_HEAD_DIM), 0.02)
    da_w_o = nrm((N_DA, D, D), D ** -0.5)
    pool_w = nrm((N_POOL, len(POOL_WINDOWS), POOL_GROUP, POOL_GROUP), POOL_GROUP ** -0.5)
    pool_scale = 1.0 + nrm((N_POOL, D), 0.1)
    mlp_w1 = nrm((DEPTH, D, D_FF), D ** -0.5)
    mlp_w2 = nrm((DEPTH, D_FF, D), D_FF ** -0.5)
    return {'x': x, 'norm_mix': norm_mix, 'norm_mlp': norm_mlp, 'norm_final': norm_final,
            's5_w_in': s5_w_in, 's5_lam_re': s5_lam_re, 's5_lam_im': s5_lam_im, 's5_log_step': s5_log_step,
            's5_b_re': s5_b_re, 's5_b_im': s5_b_im, 's5_c_re': s5_c_re, 's5_c_im': s5_c_im, 's5_d': s5_d,
            's5_w_gate': s5_w_gate, 's5_w_out': s5_w_out,
            'da_w_qkv': da_w_qkv, 'da_lam_q1': da_lam_q1, 'da_lam_k1': da_lam_k1, 'da_lam_q2': da_lam_q2,
            'da_lam_k2': da_lam_k2, 'da_subln': da_subln, 'da_w_o': da_w_o,
            'pool_w': pool_w, 'pool_scale': pool_scale, 'mlp_w1': mlp_w1, 'mlp_w2': mlp_w2}


def reference(x, norm_mix, norm_mlp, norm_final,
              s5_w_in, s5_lam_re, s5_lam_im, s5_log_step, s5_b_re, s5_b_im, s5_c_re, s5_c_im, s5_d,
              s5_w_gate, s5_w_out,
              da_w_qkv, da_lam_q1, da_lam_k1, da_lam_q2, da_lam_k2, da_subln, da_w_o,
              pool_w, pool_scale, mlp_w1, mlp_w2):
    for i in range(DEPTH):
        kind, j = i % N_MIXERS, i // N_MIXERS
        h = rmsnorm(x, norm_mix[i])
        if kind == 0:
            m = s5_mixer(h, s5_w_in[j], s5_lam_re[j], s5_lam_im[j], s5_log_step[j], s5_b_re[j], s5_b_im[j],
                         s5_c_re[j], s5_c_im[j], s5_d[j], s5_w_gate[j], s5_w_out[j])
        elif kind == 1:
            lam_init = 0.8 - 0.6 * math.exp(-0.3 * i)
            m = diff_attn_mixer(h, da_w_qkv[j], da_lam_q1[j], da_lam_k1[j], da_lam_q2[j], da_lam_k2[j],
                                da_subln[j], da_w_o[j], lam_init)
        else:
            m = pool_mixer(h, pool_w[j], pool_scale[j])
        x = x + m.astype(x.dtype)
        h = rmsnorm(x, norm_mlp[i])
        x = x + sqrelu_mlp(h, mlp_w1[i], mlp_w2[i]).astype(x.dtype)
    return rmsnorm(x, norm_final).astype(x.dtype)
```

```cpp
#include <hip/hip_runtime.h>
#include <hip/hip_cooperative_groups.h>
#include <cstdio>
#include <cstdint>
namespace cg = cooperative_groups;

#ifndef ONE_LAUNCH
#define ONE_LAUNCH 1
#endif
#ifndef ONLY_SUB
#define ONLY_SUB -1
#endif
#ifndef DIS_SUB
#define DIS_SUB -2
#endif
#define EN(x) ((ONLY_SUB < 0 || ONLY_SUB == (x)) && (x) != DIS_SUB)
#ifndef REP_MASK
#define REP_MASK 0ull
#endif
#ifndef SSM_GEMM
#define SSM_GEMM 1
#endif

#define LAS __attribute__((address_space(3)))
typedef unsigned short bf16_t;
typedef short bf16x8 __attribute__((ext_vector_type(8)));
typedef float f32x4 __attribute__((ext_vector_type(4)));
typedef float f32x16 __attribute__((ext_vector_type(16)));
typedef unsigned u32x4 __attribute__((ext_vector_type(4)));
typedef unsigned u32x2 __attribute__((ext_vector_type(2)));

constexpr int NB = 16, SEQ = 2048, T = NB * SEQ, D = 1024, FF = 4096;
constexpr float EPS = 1e-6f;
constexpr size_t MiB = 1u << 20;
constexpr size_t WS_STATS = 464 * MiB;
constexpr size_t WS_ROPE = 2 * MiB;
constexpr size_t WS_MISC = 2 * MiB + 512 * 1024;
constexpr size_t WS_WIN = 3 * MiB, WS_WGATE = 7 * MiB, WS_WOUT = 11 * MiB;
constexpr size_t WS_WQK = 15 * MiB;
constexpr size_t WS_WV = 19 * MiB;
constexpr size_t WS_WO = 21 * MiB;
constexpr size_t WS_WPOOL = 23 * MiB;
constexpr size_t WS_W1 = 24 * MiB, WS_W2 = 56 * MiB;
constexpr size_t WS_WST = 88 * MiB;
constexpr size_t WS_WSO = 120 * MiB;
constexpr size_t WS_XB = 144 * MiB;
constexpr size_t WS_R = 208 * MiB;
constexpr size_t WS_END = 468 * MiB;
constexpr size_t WS_RSD = WS_MISC + 65536;
constexpr size_t WS_BAR = WS_MISC + 409600;
constexpr size_t WS_APW = WS_MISC + 262144;

__device__ __forceinline__ unsigned cvt_pk_bf16(float lo, float hi) { unsigned r; asm volatile("v_cvt_pk_bf16_f32 %0, %1, %2" : "=v"(r) : "v"(lo), "v"(hi)); return r; }
__device__ __forceinline__ float bf2f(unsigned short b) { return __uint_as_float(((unsigned)b) << 16); }
__device__ __forceinline__ float bflo(unsigned w) { return __uint_as_float(w << 16); }
__device__ __forceinline__ float bfhi(unsigned w) { return __uint_as_float(w & 0xffff0000u); }
__device__ __forceinline__ unsigned short f2bf(float f) { unsigned u = __float_as_uint(f); return (unsigned short)((u + 0x7fffu + ((u >> 16) & 1u)) >> 16); }
__device__ __forceinline__ float gelu_tanh(float y) { const float a = 1.5957691216f * (y + 0.044715f * y * y * y); return y / (1.f + __expf(-a)); }
__device__ __forceinline__ float sigmoidf_(float a) { return 1.f / (1.f + __expf(-a)); }
#define GAS __attribute__((address_space(1)))
typedef GAS u32x4 g_u32x4; typedef GAS u32x2 g_u32x2; typedef GAS f32x4 g_f32x4; typedef GAS float g_f32;
__device__ __forceinline__ u32x4 gld16(const void* p) { return *(const g_u32x4*)p; }
__device__ __forceinline__ f32x4 gldf4(const void* p) { return *(const g_f32x4*)p; }
__device__ __forceinline__ void gst16(void* p, u32x4 v) { *(g_u32x4*)p = v; }
__device__ __forceinline__ void gst16nt(void* p, u32x4 v) { __builtin_nontemporal_store(v, (g_u32x4*)p); }
__device__ __forceinline__ void gstf(void* p, float v) { *(g_f32*)p = v; }
__device__ __forceinline__ f32x4 gldf4nt(const void* p) { return __builtin_nontemporal_load((const g_f32x4*)p); }
__device__ __forceinline__ float red4(float s) {
    { auto rr = __builtin_amdgcn_permlane16_swap(__float_as_uint(s), __float_as_uint(s), false, false); s = __uint_as_float(rr[0]) + __uint_as_float(rr[1]); }
    { auto rr = __builtin_amdgcn_permlane32_swap(__float_as_uint(s), __float_as_uint(s), false, false); s = __uint_as_float(rr[0]) + __uint_as_float(rr[1]); }
    return s; }
__device__ __forceinline__ float rstd_of(const float* ss, int row) { const g_f32x4* p = (const g_f32x4*)(ss + (size_t)row * 16); const f32x4 a = p[0], b = p[1], c = p[2], d = p[3];
    const float s = ((a[0] + a[1]) + (a[2] + a[3])) + ((b[0] + b[1]) + (b[2] + b[3])) + (((c[0] + c[1]) + (c[2] + c[3])) + ((d[0] + d[1]) + (d[2] + d[3]))); return rsqrtf(s * (1.0f / 1024.0f) + EPS); }
__device__ __forceinline__ float rstd_epi(const float* ss, int row, int fq) { const f32x4 a = *(const f32x4*)(ss + (size_t)row * 16 + fq * 4); const float s = red4((a[0] + a[1]) + (a[2] + a[3])); return rsqrtf(s * (1.0f / 1024.0f) + EPS); }

namespace pg8 {
constexpr int BM = 256, BK = 64, HALF = 128, HTB = HALF * BK * 2, STAGE_BYTES = 8 * HTB, NXCD = 8, WGM = 8;
__host__ __device__ __forceinline__ int lds_byte(int r, int c) { const int st = (r >> 4) * 2 + (c >> 5), rr = r & 15, cc = c & 31, ob = rr * 64 + cc * 2; return st * 1024 + (ob ^ (((ob >> 9) & 1) << 5)); }
__host__ __device__ __forceinline__ void stage_rc(int b, int& R, int& C) { const int st = b / 1024, sb = b % 1024, swz = sb ^ (((sb >> 9) & 1) << 5); R = (st >> 1) * 16 + swz / 64; C = (st & 1) * 32 + (swz % 64) / 2; }
__host__ __device__ __forceinline__ int perm32(int rho) { const int n = rho >> 4, i = rho & 15; return 8 * (i >> 2) + 4 * n + (i & 3); }

struct Unit { int pm, pn, om, on; };
struct Opnd { const char* base; const char* base2; size_t tstep, hstep; unsigned rowB, c16B; };
__device__ __forceinline__ Opnd mk_opnd(const void* base, int K) { Opnd o; o.base = (const char*)base; o.base2 = o.base; o.rowB = (unsigned)K * 2u; o.tstep = (size_t)256 * o.rowB; o.hstep = (size_t)128 * o.rowB; o.c16B = 32; return o; }

struct Order {
    int mode, nM, nN, nwg, G, c, div, modm, onpn;
    __device__ void init_std(int M, int N, int G_, int c_) { mode = 0; nM = M / BM; nN = N / BM; nwg = nM * nN; G = G_; c = c_; div = 1; modm = 0; onpn = 0; }
    __device__ void init_grp(int nunits, int div_, int modm_, int onpn_, int G_, int c_) { mode = 1; nM = nunits; nN = 1; nwg = nunits; G = G_; c = c_; div = div_; modm = modm_; onpn = onpn_; }
    __device__ bool next(int i, Unit& u) const {
        const long L = (long)i * G + c; if (L >= nwg) return false;
        if (mode == 0) {
            int wgid = (int)L; { const int q = nwg / NXCD, r = nwg % NXCD, xcd = wgid % NXCD, off = wgid / NXCD; wgid = (xcd < r ? xcd * (q + 1) : r * (q + 1) + (xcd - r) * q) + off; }
            const int nig = WGM * nN, gid = wgid / nig, fm = gid * WGM, gsz = (nM - fm) < WGM ? (nM - fm) : WGM;
            u.pm = fm + ((wgid % nig) % gsz); u.pn = (wgid % nig) / gsz; u.om = u.pm; u.on = u.pn;
        } else {
            u.pm = (int)L; u.pn = (int)L / div; u.om = modm ? ((int)L % modm) : (int)L; u.on = onpn ? u.pn : 0;
        }
        return true;
    }
};

#define EPI_ARGS const f32x4 (&acc)[2][2][4][2], const Unit& u, int wr, int wc, int fr, int fq
__device__ __forceinline__ u32x4 pack8(f32x4 v0, f32x4 v1) { u32x4 w; w.x = cvt_pk_bf16(v0[0], v0[1]); w.y = cvt_pk_bf16(v0[2], v0[3]); w.z = cvt_pk_bf16(v1[0], v1[1]); w.w = cvt_pk_bf16(v1[2], v1[3]); return w; }

template <int ACT, int UMODE> struct EpiScaleBf16 {
    static constexpr bool PERM = true, AFTER_DRAIN = false;
    bf16_t* O; size_t ldc; const float* ss;
    __device__ __forceinline__ void operator()(EPI_ARGS) const {
        const int row0 = u.om * BM + wr * 64 + fr, col0 = u.on * BM + wc * 32 + 8 * fq;
        float rs[2][4];
        { f32x4 pa[2][4];
#pragma unroll
          for (int ai = 0; ai < 2; ++ai)
#pragma unroll
              for (int m = 0; m < 4; ++m) pa[ai][m] = gldf4(ss + (size_t)(row0 + ai * HALF + m * 16) * 16 + fq * 4);
#pragma unroll
          for (int ai = 0; ai < 2; ++ai)
#pragma unroll
              for (int m = 0; m < 4; ++m) rs[ai][m] = rsqrtf(red4((pa[ai][m][0] + pa[ai][m][1]) + (pa[ai][m][2] + pa[ai][m][3])) * (1.0f / 1024.0f) + EPS); }
#pragma unroll
        for (int ai = 0; ai < 2; ++ai)
#pragma unroll
            for (int m = 0; m < 4; ++m) { const int row = row0 + ai * HALF + m * 16; const float r = rs[ai][m];
#pragma unroll
                for (int bj = 0; bj < 2; ++bj) { f32x4 v0 = acc[ai][bj][m][0] * r, v1 = acc[ai][bj][m][1] * r;
                    if (ACT == 1) {
#pragma unroll
                        for (int j = 0; j < 4; ++j) { const float x = fmaxf(v0[j], 0.f), y = fmaxf(v1[j], 0.f); v0[j] = x * x; v1[j] = y * y; } }
                    const int c = col0 + bj * HALF;
                    if (UMODE == 0) { if (ACT == 1) gst16nt(O + (size_t)row * ldc + c, pack8(v0, v1)); else gst16(O + (size_t)row * ldc + c, pack8(v0, v1)); }
                    else { const int g = c >> 4, h0 = c & 15; gst16(O + ((size_t)(g * 2048 + (row >> 4)) * 256 + (row & 15) * 16 + h0), pack8(v0, v1)); } } }
    }
};
struct EpiF32 {
    static constexpr bool PERM = true, AFTER_DRAIN = false;
    float* C; size_t ldc;
    __device__ __forceinline__ void operator()(EPI_ARGS) const {
        const int row0 = u.om * BM + wr * 64 + fr, col0 = u.on * BM + wc * 32 + 8 * fq;
#pragma unroll
        for (int ai = 0; ai < 2; ++ai)
#pragma unroll
            for (int m = 0; m < 4; ++m) { float* rp = C + (size_t)(row0 + ai * HALF + m * 16) * ldc + col0;
#pragma unroll
                for (int bj = 0; bj < 2; ++bj) { *(f32x4*)(rp + bj * HALF) = acc[ai][bj][m][0]; *(f32x4*)(rp + bj * HALF + 4) = acc[ai][bj][m][1]; } }
    }
};
struct EpiScan {
    static constexpr bool PERM = true, AFTER_DRAIN = true;
    bf16_t* HB; const f32x4* APW;
    __device__ __forceinline__ void operator()(EPI_ARGS) const {}
    __device__ __forceinline__ void fused(EPI_ARGS, LAS unsigned char* lds, int tid) const {
        constexpr int PITCH = 260;
        LAS float* L = (LAS float*)lds; const int g = u.pn, rt = u.pm & 3;
#pragma unroll
        for (int ai = 0; ai < 2; ++ai) {
#pragma unroll
            for (int m = 0; m < 4; ++m)
#pragma unroll
                for (int bj = 0; bj < 2; ++bj) { LAS float* d = L + (wr * 64 + m * 16 + fr) * PITCH + bj * HALF + wc * 32 + 8 * fq; *(LAS f32x4*)d = acc[ai][bj][m][0]; *(LAS f32x4*)(d + 4) = acc[ai][bj][m][1]; }
            __syncthreads();
            if (tid < 128) { const int bb = tid >> 6, p = tid & 63, b = rt * 4 + ai * 2 + bb; const f32x4 aw = gldf4(APW + g * 64 + p);
                const LAS float* sp = L + (bb * 64) * PITCH + p; GAS bf16_t* hp = (GAS bf16_t*)(HB + ((size_t)g * 2048 + b * 128) * 256 + p);
                float hr = 0.f, hi = 0.f;
#pragma unroll 4
                for (int m = 0; m < 64; ++m) {
                    const float s16r = sp[m * PITCH], s16i = sp[m * PITCH + 64], s32r = sp[m * PITCH + 128], s32i = sp[m * PITCH + 192];
                    hp[(2 * m) * 256] = f2bf(hr); hp[(2 * m) * 256 + 64] = f2bf(hi);
                    const float h1r = aw[0] * hr - aw[1] * hi + s16r, h1i = aw[0] * hi + aw[1] * hr + s16i;
                    hp[(2 * m + 1) * 256] = f2bf(h1r); hp[(2 * m + 1) * 256 + 64] = f2bf(h1i);
                    const float nr = aw[2] * hr - aw[3] * hi + s32r, ni = aw[2] * hi + aw[3] * hr + s32i; hr = nr; hi = ni; } }
            __syncthreads();
        }
    }
};
template <int ZMODE> struct EpiGate {
    static constexpr bool PERM = true, AFTER_DRAIN = false;
    const bf16_t* Z; bf16_t* O;
    __device__ __forceinline__ const bf16_t* zaddr(int row, int c) const { return ZMODE == 0 ? Z + (size_t)row * D + c : Z + ((size_t)(c >> 4) * T + row) * 16 + (c & 15); }
    __device__ __forceinline__ void operator()(EPI_ARGS) const {
        const int row0 = u.om * BM + wr * 64 + fr, col0 = u.on * BM + wc * 32 + 8 * fq;
        u32x4 zn0 = gld16(zaddr(row0, col0)), zn1 = gld16(zaddr(row0, col0 + HALF));
#pragma unroll
        for (int idx = 0; idx < 8; ++idx) { const int ai = idx >> 2, m = idx & 3, row = row0 + ai * HALF + m * 16; const u32x4 zc[2] = {zn0, zn1};
            if (idx < 7) { const int rn = row0 + ((idx + 1) >> 2) * HALF + ((idx + 1) & 3) * 16; zn0 = gld16(zaddr(rn, col0)); zn1 = gld16(zaddr(rn, col0 + HALF)); }
#pragma unroll
            for (int bj = 0; bj < 2; ++bj) { const int c = col0 + bj * HALF; const u32x4 zw = zc[bj];
                f32x4 v0 = acc[ai][bj][m][0], v1 = acc[ai][bj][m][1];
                v0[0] = bflo(zw.x) * sigmoidf_(v0[0]); v0[1] = bfhi(zw.x) * sigmoidf_(v0[1]); v0[2] = bflo(zw.y) * sigmoidf_(v0[2]); v0[3] = bfhi(zw.y) * sigmoidf_(v0[3]);
                v1[0] = bflo(zw.z) * sigmoidf_(v1[0]); v1[1] = bfhi(zw.z) * sigmoidf_(v1[1]); v1[2] = bflo(zw.w) * sigmoidf_(v1[2]); v1[3] = bfhi(zw.w) * sigmoidf_(v1[3]);
                gst16(O + (size_t)row * D + c, pack8(v0, v1)); } }
    }
};
struct EpiRes {
    static constexpr bool PERM = true, AFTER_DRAIN = false;
    bf16_t* xb; float* ssn;
    __device__ __forceinline__ void operator()(EPI_ARGS) const {
        const int row0 = u.om * BM + wr * 64 + fr, col0 = u.on * BM + wc * 32 + 8 * fq;
        u32x4 xn0 = gld16(xb + (size_t)row0 * D + col0), xn1 = gld16(xb + (size_t)row0 * D + col0 + HALF);
#pragma unroll
        for (int idx = 0; idx < 8; ++idx) { const int ai = idx >> 2, m = idx & 3, row = row0 + ai * HALF + m * 16; const u32x4 xc[2] = {xn0, xn1}; float sq = 0.f;
            if (idx < 7) { const int rn = row0 + ((idx + 1) >> 2) * HALF + ((idx + 1) & 3) * 16; xn0 = gld16(xb + (size_t)rn * D + col0); xn1 = gld16(xb + (size_t)rn * D + col0 + HALF); }
#pragma unroll
            for (int bj = 0; bj < 2; ++bj) { const size_t off = (size_t)row * D + col0 + bj * HALF; const u32x4 xo = xc[bj];
                f32x4 v0 = acc[ai][bj][m][0], v1 = acc[ai][bj][m][1];
                v0[0] += bflo(xo.x); v0[1] += bfhi(xo.x); v0[2] += bflo(xo.y); v0[3] += bfhi(xo.y); v1[0] += bflo(xo.z); v1[1] += bfhi(xo.z); v1[2] += bflo(xo.w); v1[3] += bfhi(xo.w);
                const u32x4 w = pack8(v0, v1); gst16(xb + off, w);
                const float r0 = bflo(w.x), r1 = bfhi(w.x), r2 = bflo(w.y), r3 = bfhi(w.y), r4 = bflo(w.z), r5 = bfhi(w.z), r6 = bflo(w.w), r7 = bfhi(w.w);
                sq += (r0 * r0 + r1 * r1) + (r2 * r2 + r3 * r3) + (r4 * r4 + r5 * r5) + (r6 * r6 + r7 * r7); }
            sq = red4(sq);
            if (fq == 0) gstf(ssn + (size_t)row * 16 + u.on * 4 + wc, sq); }
    }
};
struct EpiQK {
    static constexpr bool PERM = true, AFTER_DRAIN = false;
    bf16_t* Q; bf16_t* Kq; const float* ss; const float* ropec; const float* ropes; float qscale;
    __device__ __forceinline__ void operator()(EPI_ARGS) const {
        const int row0 = u.om * BM + wr * 64 + fr; const int isk = u.on >> 2, t4 = u.on & 3;
        bf16_t* base = isk ? Kq : Q; const float sc = isk ? 1.f : qscale;
        const int colf = t4 * 256 + wc * 64 + 8 * fq;
        float rs[8];
        { f32x4 pa[8];
#pragma unroll
          for (int idx = 0; idx < 8; ++idx) pa[idx] = gldf4(ss + (size_t)(row0 + (idx >> 2) * HALF + (idx & 3) * 16) * 16 + fq * 4);
#pragma unroll
          for (int idx = 0; idx < 8; ++idx) rs[idx] = rsqrtf(red4((pa[idx][0] + pa[idx][1]) + (pa[idx][2] + pa[idx][3])) * (1.0f / 1024.0f) + EPS) * sc; }
        const int p0 = (row0 & (SEQ - 1)) * 32 + 8 * fq;
        f32x4 cn0 = gldf4(ropec + p0), cn1 = gldf4(ropec + p0 + 4), sn0 = gldf4(ropes + p0), sn1 = gldf4(ropes + p0 + 4);
#pragma unroll
        for (int idx = 0; idx < 8; ++idx) { const int ai = idx >> 2, m = idx & 3, row = row0 + ai * HALF + m * 16; const float r = rs[idx];
            const f32x4 c0 = cn0, c1 = cn1, s0 = sn0, s1 = sn1;
            if (idx < 7) { const int rn = row0 + ((idx + 1) >> 2) * HALF + ((idx + 1) & 3) * 16, pn = (rn & (SEQ - 1)) * 32 + 8 * fq; cn0 = gldf4(ropec + pn); cn1 = gldf4(ropec + pn + 4); sn0 = gldf4(ropes + pn); sn1 = gldf4(ropes + pn + 4); }
            const f32x4 a0 = acc[ai][0][m][0] * r, a1 = acc[ai][0][m][1] * r, b0 = acc[ai][1][m][0] * r, b1 = acc[ai][1][m][1] * r;
            const f32x4 o0 = a0 * c0 - b0 * s0, o1 = a1 * c1 - b1 * s1, q0 = b0 * c0 + a0 * s0, q1 = b1 * c1 + a1 * s1;
            gst16(base + (size_t)row * D + colf, pack8(o0, o1)); gst16(base + (size_t)row * D + colf + 32, pack8(q0, q1)); }
    }
};
struct EpiVT {
    static constexpr bool PERM = true, AFTER_DRAIN = false;
    bf16_t* O; const float* ss; LAS unsigned char* ldsx;
    __device__ __forceinline__ void operator()(EPI_ARGS) const {
        const int row0 = u.om * BM + wr * 64 + fr, col0 = u.on * BM + wc * 32 + 8 * fq; const int lane = fq * 16 + fr;
        LAS float* tb = (LAS float*)(ldsx + (wr * 4 + wc) * 256);
        tb[lane] = rstd_of(ss, u.on * BM + wc * 32 + 128 * (lane >> 5) + (lane & 31));
        asm volatile("s_waitcnt lgkmcnt(0)" ::: "memory");
#pragma unroll
        for (int bj = 0; bj < 2; ++bj) { const int c = col0 + bj * HALF; const f32x4 r0 = *(const LAS f32x4*)(tb + bj * 32 + 8 * fq), r1 = *(const LAS f32x4*)(tb + bj * 32 + 8 * fq + 4);
#pragma unroll
            for (int ai = 0; ai < 2; ++ai)
#pragma unroll
                for (int m = 0; m < 4; ++m) { const int row = row0 + ai * HALF + m * 16; gst16(O + (size_t)row * T + c, pack8(acc[ai][bj][m][0] * r0, acc[ai][bj][m][1] * r1)); } }
    }
};
struct EpiSsmOut {
    static constexpr bool PERM = true, AFTER_DRAIN = false;
    const bf16_t* AUG; bf16_t* Z; const float* dsk;
    __device__ __forceinline__ void operator()(EPI_ARGS) const {
        const int row0 = u.om * BM + wr * 64 + fr, col0 = wc * 32 + 8 * fq; const int g = u.pn;
        const f32x4 d0 = gldf4(dsk + g * 16 + (col0 & 15)), d1 = gldf4(dsk + g * 16 + (col0 & 15) + 4);
        u32x4 un0 = gld16(AUG + (size_t)row0 * 256 + col0), un1 = gld16(AUG + (size_t)row0 * 256 + col0 + HALF);
#pragma unroll
        for (int idx = 0; idx < 8; ++idx) { const int ai = idx >> 2, m = idx & 3, row = row0 + ai * HALF + m * 16; const u32x4 uc[2] = {un0, un1};
            if (idx < 7) { const int rn = row0 + ((idx + 1) >> 2) * HALF + ((idx + 1) & 3) * 16; un0 = gld16(AUG + (size_t)rn * 256 + col0); un1 = gld16(AUG + (size_t)rn * 256 + col0 + HALF); }
#pragma unroll
            for (int bj = 0; bj < 2; ++bj) { const int c = col0 + bj * HALF; const u32x4 uw = uc[bj];
                f32x4 v0 = acc[ai][bj][m][0], v1 = acc[ai][bj][m][1];
                v0[0] = gelu_tanh(v0[0] + d0[0] * bflo(uw.x)); v0[1] = gelu_tanh(v0[1] + d0[1] * bfhi(uw.x)); v0[2] = gelu_tanh(v0[2] + d0[2] * bflo(uw.y)); v0[3] = gelu_tanh(v0[3] + d0[3] * bfhi(uw.y));
                v1[0] = gelu_tanh(v1[0] + d1[0] * bflo(uw.z)); v1[1] = gelu_tanh(v1[1] + d1[1] * bfhi(uw.z)); v1[2] = gelu_tanh(v1[2] + d1[2] * bflo(uw.w)); v1[3] = gelu_tanh(v1[3] + d1[3] * bfhi(uw.w));
                gst16(Z + (size_t)row * 256 + c, pack8(v0, v1)); } }
    }
};

template <class Epi, size_t KSA = 128, int KSPLIT = 0, bool ALIGN_EPI = true, bool SP2 = true, bool A_NT = false>
__device__ __forceinline__ void gemm_phase(const int tid, LAS unsigned char* lds, const Opnd oa, const Opnd ob, const int K, const Order& S, const Epi& E) {
    const int wid = __builtin_amdgcn_readfirstlane(tid >> 6), lane = tid & 63, wr = wid >> 2, wc = wid & 3, fr = lane & 15, fq = lane >> 4;
    const int nt = K / BK;
    unsigned voffA[2], voffB[2];
#pragma unroll
    for (int i = 0; i < 2; ++i) { int R, C; stage_rc(tid * 16 + i * 8192, R, C); const int Rb = Epi::PERM ? ((R & ~31) + perm32(R & 31)) : R;
        voffA[i] = (unsigned)R * oa.rowB + (unsigned)(C >> 4) * oa.c16B + (unsigned)(C & 15) * 2u; voffB[i] = (unsigned)Rb * ob.rowB + (unsigned)(C >> 4) * ob.c16B + (unsigned)(C & 15) * 2u; }
    const size_t hA = oa.hstep, hB = ob.hstep;
    const unsigned ldsw = (unsigned)wid * 1024u;
    const int aoff = lds_byte(wr * 64 + fr, fq * 8), boff = lds_byte(wc * 32 + fr, fq * 8);
#define PG8_SA(b, h) (((b) * 2 + (h)) * HTB)
#define PG8_SB(b, h) ((4 + (b) * 2 + (h)) * HTB)
    constexpr int AUXA = A_NT ? 2 : 0;
#define PG8_STAGEX(bufoff, gbase, voff, AUX) do { _Pragma("unroll") for (int _i = 0; _i < 2; ++_i) \
        __builtin_amdgcn_global_load_lds((const unsigned*)((const char*)(gbase) + (voff)[_i]), (LAS unsigned*)(lds + (bufoff) + ldsw + _i * 8192), 16, 0, AUX); } while (0)
#define PG8_STAGE(bufoff, gbase, voff) PG8_STAGEX(bufoff, gbase, voff, 0)
#define PG8_LDA(dst, b, h) do { _Pragma("unroll") for (int m = 0; m < 4; ++m) _Pragma("unroll") for (int k = 0; k < 2; ++k) dst[m][k] = *(const LAS bf16x8*)(lds + PG8_SA(b, h) + aoff + m * 2048 + k * 1024); } while (0)
#define PG8_LDB(dst, b, h) do { _Pragma("unroll") for (int n = 0; n < 2; ++n) _Pragma("unroll") for (int k = 0; k < 2; ++k) dst[n][k] = *(const LAS bf16x8*)(lds + PG8_SB(b, h) + boff + n * 2048 + k * 1024); } while (0)
#define PG8_MMA(ai, bj, At, Bt) do { __builtin_amdgcn_s_setprio(1); _Pragma("unroll") for (int m = 0; m < 4; ++m) _Pragma("unroll") for (int n = 0; n < 2; ++n) _Pragma("unroll") for (int k = 0; k < 2; ++k) \
        acc[ai][bj][m][n] = __builtin_amdgcn_mfma_f32_16x16x32_bf16(Bt[n][k], At[m][k], acc[ai][bj][m][n], 0, 0, 0); __builtin_amdgcn_s_setprio(0); } while (0)
#define PG8_WAIT_V(n) asm volatile("s_waitcnt vmcnt(" #n ")" ::: "memory")
#define PG8_WAIT_L(n) asm volatile("s_waitcnt lgkmcnt(" #n ")" ::: "memory")
#define PG8_BAR __builtin_amdgcn_s_barrier()
#define PG8_SCHED __builtin_amdgcn_sched_barrier(0)
    Unit cur, nxt; int ui = 0;
    if (!S.next(0, cur)) return;
    f32x4 acc[2][2][4][2];
#pragma unroll
    for (int a = 0; a < 2; ++a)
#pragma unroll
        for (int b = 0; b < 2; ++b)
#pragma unroll
            for (int m = 0; m < 4; ++m)
#pragma unroll
                for (int n = 0; n < 2; ++n) acc[a][b][m][n] = (f32x4){0.f, 0.f, 0.f, 0.f};
    bf16x8 At[4][2], B0[2][2], B1[2][2];
    const char* cA = oa.base + (size_t)cur.pm * oa.tstep; const char* cB = ob.base + (size_t)cur.pn * ob.tstep; const char* cA2 = oa.base2 + (size_t)cur.pm * oa.tstep;
    constexpr size_t kA1 = KSA, kB1 = 128;
#define PG8_ATILE(c, c2, t) ((KSPLIT > 0 && (t) >= KSPLIT) ? (c2) + (size_t)((t) - KSPLIT) * KSA : (c) + (size_t)(t) * KSA)
    if constexpr (SP2) {
        PG8_STAGE(PG8_SB(0, 0), cB, voffB); PG8_STAGE(PG8_SB(0, 1), cB + hB, voffB); PG8_STAGEX(PG8_SA(0, 0), cA, voffA, AUXA); PG8_STAGEX(PG8_SA(0, 1), cA + hA, voffA, AUXA);
        if (wr == 1) PG8_BAR;
        PG8_WAIT_V(2); PG8_BAR;
        PG8_STAGE(PG8_SB(1, 0), cB + kB1, voffB); PG8_STAGEX(PG8_SA(1, 0), cA + kA1, voffA, AUXA); PG8_STAGE(PG8_SB(1, 1), cB + hB + kB1, voffB);
        PG8_WAIT_V(6); PG8_BAR;
    } else {
        PG8_STAGE(PG8_SB(0, 0), cB, voffB); PG8_STAGEX(PG8_SA(0, 0), cA, voffA, AUXA); PG8_STAGE(PG8_SB(0, 1), cB + hB, voffB); PG8_STAGEX(PG8_SA(0, 1), cA + hA, voffA, AUXA);
        if (wr == 1) PG8_BAR;
        PG8_WAIT_V(4); PG8_BAR;
        PG8_STAGE(PG8_SB(1, 0), cB + kB1, voffB); PG8_STAGEX(PG8_SA(1, 0), cA + kA1, voffA, AUXA); PG8_STAGE(PG8_SB(1, 1), cB + hB + kB1, voffB);
        PG8_WAIT_V(6); PG8_BAR;
    }
    for (;;) {
        const bool has_next = S.next(ui + 1, nxt);
        const char* nA = has_next ? oa.base + (size_t)nxt.pm * oa.tstep : cA; const char* nA2 = has_next ? oa.base2 + (size_t)nxt.pm * oa.tstep : cA2; const char* nB = has_next ? ob.base + (size_t)nxt.pn * ob.tstep : cB;
#pragma nounroll
        for (int t = 0; t < nt; t += 2) {
            const bool last = (t == nt - 2);
            const char* a1 = PG8_ATILE(cA, cA2, t + 1);
            const char* a2 = last ? nA : PG8_ATILE(cA, cA2, t + 2); const char* b2 = last ? nB : cB + (size_t)(t + 2) * 128;
            const char* a3 = last ? nA + kA1 : PG8_ATILE(cA, cA2, t + 3); const char* b3 = b2 + kB1;
            if constexpr (SP2) {
            PG8_LDB(B0, 0, 0); PG8_LDB(B1, 0, 1); PG8_SCHED; PG8_LDA(At, 0, 0); PG8_STAGEX(PG8_SA(1, 1), a1 + hA, voffA, AUXA);
            PG8_WAIT_V(8); PG8_WAIT_L(0); PG8_BAR; PG8_MMA(0, 0, At, B0); PG8_MMA(0, 1, At, B1); PG8_BAR; PG8_SCHED;
            PG8_LDA(At, 0, 1); PG8_STAGE(PG8_SB(0, 0), b2, voffB); PG8_STAGE(PG8_SB(0, 1), b2 + hB, voffB); PG8_STAGEX(PG8_SA(0, 0), a2, voffA, AUXA);
            PG8_WAIT_V(8); PG8_WAIT_L(0); PG8_BAR; PG8_MMA(1, 0, At, B0); PG8_MMA(1, 1, At, B1); PG8_BAR; PG8_SCHED;
            PG8_LDB(B0, 1, 0); PG8_LDB(B1, 1, 1); PG8_SCHED; PG8_LDA(At, 1, 0); PG8_STAGEX(PG8_SA(0, 1), a2 + hA, voffA, AUXA);
            PG8_WAIT_V(8); PG8_WAIT_L(0); PG8_BAR; PG8_MMA(0, 0, At, B0); PG8_MMA(0, 1, At, B1); PG8_BAR; PG8_SCHED;
            PG8_LDA(At, 1, 1); PG8_STAGE(PG8_SB(1, 0), b3, voffB); PG8_STAGE(PG8_SB(1, 1), b3 + hB, voffB); PG8_STAGEX(PG8_SA(1, 0), a3, voffA, AUXA);
            PG8_WAIT_V(8); PG8_WAIT_L(0); PG8_BAR; PG8_MMA(1, 0, At, B0); PG8_MMA(1, 1, At, B1); PG8_BAR; PG8_SCHED;
            } else {
            PG8_LDB(B0, 0, 0); PG8_SCHED; PG8_LDA(At, 0, 0); PG8_STAGEX(PG8_SA(1, 1), a1 + hA, voffA, AUXA);
            PG8_WAIT_L(8); PG8_BAR; PG8_WAIT_L(0); PG8_MMA(0, 0, At, B0); PG8_BAR; PG8_SCHED;
            PG8_LDB(B1, 0, 1); PG8_STAGE(PG8_SB(0, 0), b2, voffB);
            PG8_BAR; PG8_WAIT_L(0); PG8_MMA(0, 1, At, B1); PG8_BAR;
            PG8_LDA(At, 0, 1); PG8_STAGEX(PG8_SA(0, 0), a2, voffA, AUXA);
            PG8_BAR; PG8_WAIT_L(0); PG8_MMA(1, 0, At, B0); PG8_BAR; PG8_SCHED;
            PG8_STAGE(PG8_SB(0, 1), b2 + hB, voffB);
            PG8_WAIT_V(6); PG8_BAR; PG8_MMA(1, 1, At, B1); PG8_BAR;
            PG8_LDB(B0, 1, 0); PG8_SCHED; PG8_LDA(At, 1, 0); PG8_STAGEX(PG8_SA(0, 1), a2 + hA, voffA, AUXA);
            PG8_WAIT_L(8); PG8_BAR; PG8_WAIT_L(0); PG8_MMA(0, 0, At, B0); PG8_BAR; PG8_SCHED;
            PG8_LDB(B1, 1, 1); PG8_STAGE(PG8_SB(1, 0), b3, voffB);
            PG8_BAR; PG8_WAIT_L(0); PG8_MMA(0, 1, At, B1); PG8_BAR;
            PG8_LDA(At, 1, 1); PG8_STAGEX(PG8_SA(1, 0), a3, voffA, AUXA);
            PG8_BAR; PG8_WAIT_L(0); PG8_MMA(1, 0, At, B0); PG8_BAR; PG8_SCHED;
            PG8_STAGE(PG8_SB(1, 1), b3 + hB, voffB);
            PG8_WAIT_V(6); PG8_BAR; PG8_MMA(1, 1, At, B1); PG8_BAR;
            }
        }
        if constexpr (ALIGN_EPI) { if (wr == 0) PG8_BAR; }
        if constexpr (!Epi::AFTER_DRAIN) E(acc, cur, wr, wc, fr, fq);
        if (!has_next) break;
#pragma unroll
        for (int a = 0; a < 2; ++a)
#pragma unroll
            for (int b = 0; b < 2; ++b)
#pragma unroll
                for (int m = 0; m < 4; ++m)
#pragma unroll
                    for (int n = 0; n < 2; ++n) acc[a][b][m][n] = (f32x4){0.f, 0.f, 0.f, 0.f};
        cur = nxt; cA = nA; cA2 = nA2; cB = nB; ++ui;
        if constexpr (ALIGN_EPI) { if (wr == 1) PG8_BAR; }
    }
    PG8_WAIT_V(0);
    if constexpr (!ALIGN_EPI) { if (wr == 0) PG8_BAR; }
    PG8_BAR;
    if constexpr (Epi::AFTER_DRAIN) E.fused(acc, cur, wr, wc, fr, fq, lds, tid);
#undef PG8_ATILE
#undef PG8_SA
#undef PG8_SB
#undef PG8_STAGE
#undef PG8_STAGEX
#undef PG8_LDA
#undef PG8_LDB
#undef PG8_MMA
#undef PG8_WAIT_V
#undef PG8_WAIT_L
#undef PG8_BAR
#undef PG8_SCHED
}
}

#define XB_TMO      128
#define XB_XCNT(j)  (256  + 64 * (j))
#define XB_XSUB(j)  (1280 + 64 * (j))
#define XB_XGEN(j)  (2304 + 64 * (j))
#define XB_TOP      3328
#define XB_TOPGEN   3392
#define XCD_BAR_WORDS 3456
#define XB_SPIN_CAP (1u << 18)

__device__ __forceinline__ unsigned xb_ld(unsigned* p)              { return __hip_atomic_load(p, __ATOMIC_RELAXED, __HIP_MEMORY_SCOPE_AGENT); }
__device__ __forceinline__ unsigned xb_add(unsigned* p, unsigned v) { return __hip_atomic_fetch_add(p, v, __ATOMIC_RELAXED, __HIP_MEMORY_SCOPE_AGENT); }
__device__ __forceinline__ unsigned xb_xcc_id() { return (unsigned)__builtin_amdgcn_s_getreg((3 << 11) | 20) & 0xFu; }
#define XB_SPIN(cond, bar) do { unsigned _sp = 0; while (cond) { __builtin_amdgcn_s_sleep(1); \
    if ((++_sp & 255u) == 0u) { if (xb_ld(&(bar)[XB_TMO])) break; if (_sp > XB_SPIN_CAP) { atomicAdd(&(bar)[XB_TMO], 1u); break; } } } } while (0)

struct XcdBarrier {
    unsigned* bar; unsigned x;
    volatile LAS unsigned* st;
};

__device__ __forceinline__ XcdBarrier xcd_barrier_post(unsigned* bar, volatile LAS unsigned* st) {
    XcdBarrier b; b.bar = bar; b.x = xb_xcc_id(); b.st = st;
    if (threadIdx.x == 0) (void)xb_add(&bar[XB_XCNT(b.x)], 1u);
    return b;
}
__device__ __forceinline__ void xcd_barrier_complete(unsigned* bar, unsigned x, unsigned& nloc, unsigned& nx) {
    const unsigned G = gridDim.x * gridDim.y * gridDim.z;
    unsigned sum, cnt, mine, sp = 0u;
    for (;;) {
        sum = 0u; cnt = 0u; mine = 0u;
#pragma unroll
        for (unsigned j = 0; j < 16; ++j) { const unsigned c = xb_ld(&bar[XB_XCNT(j)]); sum += c; cnt += (c > 0u) ? 1u : 0u; mine = (j == x) ? c : mine; }
        if (sum == G) break;
        __builtin_amdgcn_s_sleep(1);
        if ((++sp & 255u) == 0u) { if (xb_ld(&bar[XB_TMO])) break; if (sp > XB_SPIN_CAP) { atomicAdd(&bar[XB_TMO], 1u); break; } }
    }
    nloc = mine > 0u ? mine : 1u; nx = cnt > 0u ? cnt : 1u;
}

__device__ __forceinline__ void xcd_barrier(const XcdBarrier& b) {
    asm volatile("s_waitcnt vmcnt(0)" ::: "memory");
    __syncthreads();
    if (threadIdx.x == 0) {
        unsigned* bar = b.bar;
        __builtin_amdgcn_s_waitcnt(0);
        unsigned nloc = b.st[0], nx = b.st[1];
        if (nloc == 0u) { xcd_barrier_complete(bar, b.x, nloc, nx); b.st[0] = nloc; b.st[1] = nx; }
        const unsigned old = xb_add(&bar[XB_XSUB(b.x)], 1u);
        const unsigned gen = old / nloc;
        if (old + 1u == (gen + 1u) * nloc) {
            __builtin_amdgcn_fence(__ATOMIC_RELEASE, "agent");
            asm volatile("s_waitcnt vmcnt(0)" ::: "memory");
            const unsigned og = xb_add(&bar[XB_TOP], 1u);
            const unsigned tg = og / nx;
            if (og + 1u == (tg + 1u) * nx) xb_add(&bar[XB_TOPGEN], 1u);
            else XB_SPIN(xb_ld(&bar[XB_TOPGEN]) == tg, bar);
            __builtin_amdgcn_fence(__ATOMIC_ACQUIRE, "agent");
            xb_add(&bar[XB_XGEN(b.x)], 1u);
            asm volatile("s_waitcnt vmcnt(0)" ::: "memory");
        } else {
            XB_SPIN(xb_ld(&bar[XB_XGEN(b.x)]) == gen, bar);
            __builtin_amdgcn_fence(__ATOMIC_ACQUIRE, "agent");
            asm volatile("s_waitcnt vmcnt(0)" ::: "memory");
        }
    }
    __syncthreads();
}


struct Args {
    const float* in[26];
    float* out; unsigned char* ws;
    int ph_lo, ph_hi;
};
enum { I_X = 0, I_NMIX, I_NMLP, I_NFIN, I_S5WIN, I_S5LRE, I_S5LIM, I_S5STEP, I_S5BRE, I_S5BIM, I_S5CRE, I_S5CIM, I_S5D, I_S5WG, I_S5WO,
       I_DAQKV, I_DALQ1, I_DALK1, I_DALQ2, I_DALK2, I_DASUB, I_DAWO, I_POOLW, I_POOLS, I_W1, I_W2 };

constexpr int LDS_BYTES = 147456;
constexpr float LAM_INIT = 0.35550906f;
constexpr float QSCALE = 0.125f * 1.4426950408889634f;

struct Ctx { LAS unsigned char* lds; const Args* a; int tid, lane, wave, G, bid; };

__device__ __forceinline__ void transpose_item(const float* W, int K, int ldw, int k0, int n0, bf16_t* WT, int dstmode, int dst0, const float* ks, int ksmask, float kmul, const float* ns, bool usens, LAS float* scr, int lane) {
    const int l15 = lane & 15, l4 = lane >> 4;
    const f32x4 nq = *(const f32x4*)(ns + (n0 & 255) + l15 * 4); const float ns0 = usens ? nq[0] : 1.f, ns1 = usens ? nq[1] : 1.f, ns2 = usens ? nq[2] : 1.f, ns3 = usens ? nq[3] : 1.f;
#pragma unroll
    for (int i = 0; i < 16; ++i) { const int k = 4 * i + l4; f32x4 v = gldf4nt(W + (size_t)(k0 + k) * ldw + n0 + l15 * 4);
        const float sc = ks ? kmul * ks[(k0 + k) & ksmask] : kmul;
        LAS float* d = scr + k * 65 + l15 * 4; d[0] = v[0] * sc * ns0; d[1] = v[1] * sc * ns1; d[2] = v[2] * sc * ns2; d[3] = v[3] * sc * ns3; }
    asm volatile("s_waitcnt lgkmcnt(0)" ::: "memory");
    const int c = lane & 7;
#pragma unroll
    for (int j = 0; j < 8; ++j) { const int nn = (lane >> 3) + 8 * j; const LAS float* sp = scr + (8 * c) * 65 + nn;
        u32x4 o; o.x = cvt_pk_bf16(sp[0 * 65], sp[1 * 65]); o.y = cvt_pk_bf16(sp[2 * 65], sp[3 * 65]); o.z = cvt_pk_bf16(sp[4 * 65], sp[5 * 65]); o.w = cvt_pk_bf16(sp[6 * 65], sp[7 * 65]);
        int drow = dst0 + nn; if (dstmode) { const int n = n0 + nn, w = n & 255; drow = (n & ~255) + ((w & 63) >> 5) * 128 + (w >> 6) * 32 + (w & 31); }
        gst16(WT + (size_t)drow * K + k0 + 8 * c, o); }
    asm volatile("s_waitcnt lgkmcnt(0)" ::: "memory");
}

__device__ __forceinline__ void s5_item(const Ctx& F, int j, int g, int part);
__device__ __forceinline__ void prologue(const Ctx& F) {
    const Args& A = *F.a; unsigned char* ws = A.ws;
    LAS float* scr = (LAS float*)(F.lds + F.wave * 16640);
    const int gw = F.bid * 8 + F.wave, NGW = F.G * 8;
    constexpr int I_DD = (D / 64) * (D / 64);
    constexpr int I_QKV = (D / 64) * (3 * D / 64);
    constexpr int I_POOL = 4 * 4 * 4;
    constexpr int I_MLP = (D / 64) * (FF / 64);
    constexpr int NITEMS = 6 * I_DD + I_QKV + I_DD + I_POOL + 8 * I_MLP;
    for (int it = gw; it < NITEMS; it += NGW) {
        int r = it;
        const float* W; int K, ldw, kb, nb, dstmode = 0, dsub = 0, ksmask = D - 1; bf16_t* WT; const float* ks = nullptr; float kmul = 1.f; const float* ns = A.in[I_POOLS]; bool usens = false;
        if (r < 6 * I_DD) { const int which = r / I_DD, j = which & 1, kind = which >> 1; r %= I_DD; kb = r / (D / 64); nb = r % (D / 64); K = D; ldw = D;
            W = (kind == 0 ? A.in[I_S5WIN] : kind == 1 ? A.in[I_S5WG] : A.in[I_S5WO]) + (size_t)j * D * D;
            WT = (bf16_t*)(ws + (kind == 0 ? WS_WIN : kind == 1 ? WS_WGATE : WS_WOUT) + (size_t)j * 2 * MiB);
            if (kind == 0) ks = A.in[I_NMIX] + (j ? 3 : 0) * D; }
        else if ((r -= 6 * I_DD) < I_QKV) { kb = r / (3 * D / 64); nb = r % (3 * D / 64); K = D; ldw = 3 * D; W = A.in[I_DAQKV]; ks = A.in[I_NMIX] + 1 * D;
            if (nb < 32) { WT = (bf16_t*)(ws + WS_WQK); dstmode = 1; } else { WT = (bf16_t*)(ws + WS_WV); dsub = 2048; } }
        else if ((r -= I_QKV) < I_DD) { kb = r / (D / 64); nb = r % (D / 64); K = D; ldw = D; W = A.in[I_DAWO]; WT = (bf16_t*)(ws + WS_WO); ks = A.in[I_DASUB]; ksmask = 127; kmul = 1.f - LAM_INIT; }
        else if ((r -= I_DD) < I_POOL) { const int g = r / 16, q = r % 16; kb = q / 4; nb = q % 4; K = 256; ldw = 256; W = A.in[I_POOLW] + (size_t)g * 65536; WT = (bf16_t*)(ws + WS_WPOOL) + (size_t)g * 65536;
            ks = A.in[I_NMIX] + 2 * D + g * 256; ksmask = 255; ns = A.in[I_POOLS] + g * 256; usens = true; }
        else { r -= I_POOL; const int which = r / I_MLP; r %= I_MLP; const int i = which >> 1;
            if ((which & 1) == 0) { kb = r / (FF / 64); nb = r % (FF / 64); K = D; ldw = FF; W = A.in[I_W1] + (size_t)i * D * FF; WT = (bf16_t*)(ws + WS_W1 + (size_t)i * 8 * MiB); ks = A.in[I_NMLP] + i * D; }
            else { kb = r / (D / 64); nb = r % (D / 64); K = FF; ldw = D; W = A.in[I_W2] + (size_t)i * D * FF; WT = (bf16_t*)(ws + WS_W2 + (size_t)i * 8 * MiB); } }
        transpose_item(W, K, ldw, kb * 64, nb * 64, WT, dstmode, nb * 64 - dsub, ks, ksmask, kmul, ns, usens, scr, F.lane);
    }
    float* stats = (float*)(ws + WS_STATS); bf16_t* xb = (bf16_t*)(ws + WS_XB);
    for (int m = gw; m < T; m += NGW) {
        const g_f32x4* xr = (const g_f32x4*)(A.in[I_X] + (size_t)m * D) + F.lane; float s = 0.f; g_u32x2* o8 = (g_u32x2*)(xb + (size_t)m * D) + F.lane;
        f32x4 xv[4];
#pragma unroll
        for (int j = 0; j < 4; ++j) xv[j] = __builtin_nontemporal_load(xr + 64 * j);
#pragma unroll
        for (int j = 0; j < 4; ++j) { const f32x4 v = xv[j]; s += (v[0] * v[0] + v[1] * v[1]) + (v[2] * v[2] + v[3] * v[3]); u32x2 w; w.x = cvt_pk_bf16(v[0], v[1]); w.y = cvt_pk_bf16(v[2], v[3]); o8[64 * j] = w; }
#pragma unroll
        for (int o = 1; o < 64; o <<= 1) s += __shfl_xor(s, o);
        if (F.lane < 16) stats[(size_t)m * 16 + F.lane] = F.lane == 0 ? s : 0.f;
    }
    { float* rc = (float*)(ws + WS_ROPE); float* rsn = rc + SEQ * 32;
      for (int i = F.bid * 512 + F.tid; i < SEQ * 32; i += F.G * 512) { const int pos = i >> 5, f = i & 31; const float invf = powf(10000.0f, -(float)(2 * f) / 64.0f); const float ang = (float)pos * invf; float sn, cs; sincosf(ang, &sn, &cs); rc[i] = cs; rsn[i] = sn; } }
    if (F.bid == 0 && F.wave == 0) { float a = A.in[I_DALQ1][F.lane] * A.in[I_DALK1][F.lane], b = A.in[I_DALQ2][F.lane] * A.in[I_DALK2][F.lane];
#pragma unroll
        for (int o = 1; o < 64; o <<= 1) { a += __shfl_xor(a, o); b += __shfl_xor(b, o); }
        if (F.lane == 0) ((float*)(ws + WS_MISC))[0] = expf(a) - expf(b) + LAM_INIT; }
#if SSM_GEMM
    for (int it = F.bid; it < 256; it += F.G) s5_item(F, it >> 7, (it >> 1) & 63, it & 1);
#endif
}

__device__ __forceinline__ void ssm_naive(const Ctx& F, int j, const bf16_t* U, bf16_t* Z) {
    const Args& A = *F.a; const int gw = F.bid * 8 + F.wave, NGW = F.G * 8, p = F.lane;
    for (int w = gw; w < NB * 64; w += NGW) {
        const int b = w >> 6, g = w & 63;
        const float lr = fminf(A.in[I_S5LRE][(j * 64 + g) * 64 + p], -1e-4f), li = A.in[I_S5LIM][(j * 64 + g) * 64 + p], dt = expf(A.in[I_S5STEP][j * 64 + g]);
        const float mag = expf(lr * dt); float sn, cs; sincosf(li * dt, &sn, &cs); const float are = mag * cs, aim = mag * sn;
        const float den = lr * lr + li * li, nr = are - 1.0f; const float fre = (nr * lr + aim * li) / den, fim = (aim * lr - nr * li) / den;
        float Bre[16], Bim[16], Cre[16], Cim[16];
#pragma unroll
        for (int h = 0; h < 16; ++h) { const float br = A.in[I_S5BRE][((size_t)(j * 64 + g) * 64 + p) * 16 + h], bi = A.in[I_S5BIM][((size_t)(j * 64 + g) * 64 + p) * 16 + h];
            Bre[h] = fre * br - fim * bi; Bim[h] = fre * bi + fim * br;
            Cre[h] = A.in[I_S5CRE][((size_t)(j * 64 + g) * 16 + h) * 64 + p]; Cim[h] = A.in[I_S5CIM][((size_t)(j * 64 + g) * 16 + h) * 64 + p]; }
        const float dsk = A.in[I_S5D][j * D + g * 16 + (p & 15)];
        float xr = 0.f, xi = 0.f;
        for (int t = 0; t < SEQ; ++t) {
            const size_t off = (size_t)(b * SEQ + t) * D + g * 16;
            const u32x4 u0 = *(const u32x4*)(U + off), u1 = *(const u32x4*)(U + off + 8);
            float uu[16] = {bflo(u0.x), bfhi(u0.x), bflo(u0.y), bfhi(u0.y), bflo(u0.z), bfhi(u0.z), bflo(u0.w), bfhi(u0.w), bflo(u1.x), bfhi(u1.x), bflo(u1.y), bfhi(u1.y), bflo(u1.z), bfhi(u1.z), bflo(u1.w), bfhi(u1.w)};
            float bur = 0.f, bui = 0.f;
#pragma unroll
            for (int h = 0; h < 16; ++h) { bur += Bre[h] * uu[h]; bui += Bim[h] * uu[h]; }
            const float nxr = are * xr - aim * xi + bur, nxi = are * xi + aim * xr + bui; xr = nxr; xi = nxi;
            float ysel = 0.f, usel = 0.f;
#pragma unroll
            for (int h = 0; h < 16; ++h) { float v = Cre[h] * xr - Cim[h] * xi;
#pragma unroll
                for (int o = 1; o < 64; o <<= 1) v += __shfl_xor(v, o);
                if ((p & 15) == h) { ysel = v; usel = uu[h]; } }
            if (p < 16) Z[off + p] = f2bf(gelu_tanh(ysel + dsk * usel));
        }
    }
}


__device__ __forceinline__ void s5_item(const Ctx& F, int j, int g, int part) {
    const Args& A = *F.a; unsigned char* ws = A.ws; const int tid = F.tid;
    LAS float* apr = (LAS float*)F.lds; LAS float* api = apr + 2112; LAS float* bbr = api + 2112; LAS float* bbi = bbr + 1024; LAS float* cre = bbi + 1024; LAS float* cim = cre + 1024; LAS float* Km = cim + 1024;
    __syncthreads();
    const float dt = expf(A.in[I_S5STEP][j * 64 + g]);
    for (int e = tid; e < 33 * 64; e += 512) { const int tau = e >> 6, p = e & 63;
        const float lr = fminf(A.in[I_S5LRE][(j * 64 + g) * 64 + p], -1e-4f), li = A.in[I_S5LIM][(j * 64 + g) * 64 + p];
        const float mg = __expf((float)tau * lr * dt); double rev = (double)tau * (double)li * (double)dt * 0.15915494309189535; rev -= rint(rev);
        apr[e] = mg * __builtin_amdgcn_cosf((float)rev); api[e] = mg * __builtin_amdgcn_sinf((float)rev); }
    for (int e = tid; e < 1024; e += 512) { const int p = e >> 4, h = e & 15;
        const float lr = fminf(A.in[I_S5LRE][(j * 64 + g) * 64 + p], -1e-4f), li = A.in[I_S5LIM][(j * 64 + g) * 64 + p];
        double rev = (double)li * (double)dt * 0.15915494309189535; rev -= rint(rev); const float cs = __builtin_amdgcn_cosf((float)rev), sn = __builtin_amdgcn_sinf((float)rev), sh = __builtin_amdgcn_sinf((float)(0.5 * rev));
        const float mm1 = expm1f(lr * dt), mg = mm1 + 1.f, aim = mg * sn, nr = mm1 * cs - 2.f * sh * sh;
        const float den = lr * lr + li * li, fre = (nr * lr + aim * li) / den, fim = (aim * lr - nr * li) / den;
        const float br = A.in[I_S5BRE][((size_t)(j * 64 + g) * 64 + p) * 16 + h], bi = A.in[I_S5BIM][((size_t)(j * 64 + g) * 64 + p) * 16 + h];
        bbr[e] = fre * br - fim * bi; bbi[e] = fre * bi + fim * br;
        cre[e] = A.in[I_S5CRE][(size_t)(j * 64 + g) * 1024 + e]; cim[e] = A.in[I_S5CIM][(size_t)(j * 64 + g) * 1024 + e]; }
    __syncthreads();
    if (part == 0 && tid < 64) { f32x4 v = {apr[16 * 64 + tid], api[16 * 64 + tid], apr[32 * 64 + tid], api[32 * 64 + tid]}; ((f32x4*)(ws + WS_APW))[(j * 64 + g) * 64 + tid] = v; }
    if (part == 1) for (int e = tid; e < 4096; e += 512) { const int tau = e >> 8, h = (e >> 4) & 15, hp = e & 15; float sacc = 0.f;
        for (int p = 0; p < 64; ++p) { const float cr = cre[h * 64 + p], ci = cim[h * 64 + p], ar = apr[tau * 64 + p], ai = api[tau * 64 + p]; const float wr = cr * ar - ci * ai, wi = cr * ai + ci * ar;
            sacc += wr * bbr[p * 16 + hp] - wi * bbi[p * 16 + hp]; }
        Km[e] = sacc; }
    __syncthreads();
    bf16_t* Wst = (bf16_t*)(ws + WS_WST + (size_t)j * 16 * MiB) + (size_t)g * 256 * 512;
    if (part == 0) for (int v = tid; v < 256 * 64; v += 512) { const int n = v >> 6, kv = v & 63, jtok = kv >> 1, h0 = (kv & 1) * 8, q = n >> 7, ri = (n >> 6) & 1, p = n & 63; const int e = (q ? 31 : 15) - jtok;
        float o[8];
        if (e >= 0) { const float ar = apr[e * 64 + p], ai = api[e * 64 + p];
#pragma unroll
            for (int k = 0; k < 8; ++k) { const float br = bbr[p * 16 + h0 + k], bi = bbi[p * 16 + h0 + k]; o[k] = ri ? (ar * bi + ai * br) : (ar * br - ai * bi); } }
        else {
#pragma unroll
            for (int k = 0; k < 8; ++k) o[k] = 0.f; }
        u32x4 w; w.x = cvt_pk_bf16(o[0], o[1]); w.y = cvt_pk_bf16(o[2], o[3]); w.z = cvt_pk_bf16(o[4], o[5]); w.w = cvt_pk_bf16(o[6], o[7]);
        *(u32x4*)(Wst + (size_t)n * 512 + kv * 8) = w; }
    bf16_t* Wso = (bf16_t*)(ws + WS_WSO + (size_t)j * 12 * MiB) + (size_t)g * 256 * 384;
    if (part == 1) for (int v = tid; v < 256 * 48; v += 512) { const int n = v / 48, kv = v % 48, i = n >> 4, h = n & 15;
        float o[8];
        if (kv < 32) { const int jtok = kv >> 1, h0 = (kv & 1) * 8;
#pragma unroll
            for (int k = 0; k < 8; ++k) o[k] = jtok <= i ? Km[(i - jtok) * 256 + h * 16 + h0 + k] : 0.f; }
        else { const int kk = (kv - 32) * 8, ri = kk >> 6, p0 = kk & 63;
#pragma unroll
            for (int k = 0; k < 8; ++k) { const int p = p0 + k; const float ar = apr[(i + 1) * 64 + p], ai = api[(i + 1) * 64 + p], cr = cre[h * 64 + p], ci = cim[h * 64 + p]; o[k] = ri ? -(cr * ai + ci * ar) : (cr * ar - ci * ai); } }
        u32x4 w; w.x = cvt_pk_bf16(o[0], o[1]); w.y = cvt_pk_bf16(o[2], o[3]); w.z = cvt_pk_bf16(o[4], o[5]); w.w = cvt_pk_bf16(o[6], o[7]);
        *(u32x4*)(Wso + (size_t)n * 384 + kv * 8) = w; }
    __syncthreads();
}
__device__ __forceinline__ void ssm_scan(const Ctx& F, int j, const float* Sl, bf16_t* HB) {
    const f32x4* APW = (const f32x4*)(F.a->ws + WS_APW) + j * 4096;
    for (int gt = F.bid * 512 + F.tid; gt < 65536; gt += F.G * 512) {
        const int p = gt & 63, b = (gt >> 6) & 15, g = gt >> 10;
        const f32x4 aw = APW[g * 64 + p];
        const float* sp = Sl + ((size_t)g * 1024 + b * 64) * 256 + p;
        bf16_t* hp = HB + ((size_t)g * 2048 + b * 128) * 256 + p;
        float hr = 0.f, hi = 0.f;
#pragma unroll 4
        for (int m = 0; m < 64; ++m) {
            const float s16r = sp[m * 256], s16i = sp[m * 256 + 64], s32r = sp[m * 256 + 128], s32i = sp[m * 256 + 192];
            hp[(2 * m) * 256] = f2bf(hr); hp[(2 * m) * 256 + 64] = f2bf(hi);
            const float h1r = aw[0] * hr - aw[1] * hi + s16r, h1i = aw[0] * hi + aw[1] * hr + s16i;
            hp[(2 * m + 1) * 256] = f2bf(h1r); hp[(2 * m + 1) * 256 + 64] = f2bf(h1i);
            const float nr = aw[2] * hr - aw[3] * hi + s32r, ni = aw[2] * hi + aw[3] * hr + s32i; hr = nr; hi = ni;
        }
    }
}

namespace att {
constexpr int KBUF = 16384, VBUF = 16384, BUF = KBUF + VBUF, NBUF = 3, XOFF = 0, XROW = 528, XPAIR = 32 * XROW, OROW = 272;
__device__ __forceinline__ int kap(int m) { return (m & ~12) | ((m & 4) << 1) | ((m & 8) >> 1); }
__device__ __forceinline__ void unit(const Ctx& F, int b, int h, int qb, const bf16_t* Q, const bf16_t* Kg, const bf16_t* VT, bf16_t* O, float lam) {
    LAS unsigned char* lds = F.lds; const int lane = F.lane, wid = F.wave, r32 = lane & 31, hi = lane >> 5, rg = wid >> 1, s = wid & 1;
    const size_t tok0 = (size_t)b * SEQ; const int q0 = qb * 128 + rg * 32;
    bf16x8 qf[4];
    { const bf16_t* qp = Q + (tok0 + q0 + r32) * D + h * 128 + s * 64 + hi * 8;
#pragma unroll
      for (int d0 = 0; d0 < 4; ++d0) qf[d0] = *(const GAS bf16x8*)(qp + d0 * 16); }
    f32x16 o[4];
#pragma unroll
    for (int db = 0; db < 4; ++db)
#pragma unroll
        for (int r = 0; r < 16; ++r) o[db][r] = 0.f;
    float mrun = -1e30f, lrun = 0.f;
    const int NT = qb * 2 + 2, cq = qb * 2 + (rg >> 1);
    const bf16_t* ksrc[2]; const bf16_t* vsrc[2];
#pragma unroll
    for (int i = 0; i < 2; ++i) { const int kr = 4 * (2 * wid + i) + (lane >> 4), ks = (lane & 15) ^ (kr & 15); ksrc[i] = Kg + (tok0 + kr) * D + h * 128 + ks * 8;
        const int vr = 8 * (2 * wid + i) + (lane >> 3), vs = (lane & 7) ^ ((vr >> 1) & 7); vsrc[i] = VT + (size_t)(h * 128 + vr) * T + tok0 + vs * 8; }
#define ATT_DMA(j, bofs) do { _Pragma("unroll") for (int _i = 0; _i < 2; ++_i) { \
        __builtin_amdgcn_global_load_lds((const unsigned*)(ksrc[_i] + (size_t)(j) * 64 * D), (LAS unsigned*)(lds + (bofs) + (2 * wid + _i) * 1024), 16, 0, 0); \
        __builtin_amdgcn_global_load_lds((const unsigned*)(vsrc[_i] + (size_t)(j) * 64), (LAS unsigned*)(lds + (bofs) + KBUF + (2 * wid + _i) * 1024), 16, 0, 0); } } while (0)
    const int krow = kap(r32);
    int kad[4], vad[4];
#pragma unroll
    for (int i = 0; i < 4; ++i) { kad[i] = krow * 256 + (((s * 8 + i * 2 + hi) ^ (krow & 15)) << 4); vad[i] = r32 * 128 + (((i * 2 + hi) ^ ((r32 >> 1) & 7)) << 4); }
    bf16x8 pf[4];
#define ATT_S(bofs) do { f32x16 sc[2]; bf16x8 kfr[8]; \
        _Pragma("unroll") for (int d0 = 0; d0 < 4; ++d0) _Pragma("unroll") for (int hf = 0; hf < 2; ++hf) kfr[d0 * 2 + hf] = *(const LAS bf16x8*)(lds + (kad[d0] + (bofs)) + hf * 8192); \
        _Pragma("unroll") for (int r = 0; r < 16; ++r) { sc[0][r] = 0.f; sc[1][r] = 0.f; } \
        asm volatile("s_waitcnt lgkmcnt(0)" ::: "memory"); __builtin_amdgcn_sched_barrier(0); \
        _Pragma("unroll") for (int d0 = 0; d0 < 4; ++d0) _Pragma("unroll") for (int hf = 0; hf < 2; ++hf) sc[hf] = __builtin_amdgcn_mfma_f32_32x32x16_bf16(kfr[d0 * 2 + hf], qf[d0], sc[hf], 0, 0, 0); \
        __builtin_amdgcn_sched_barrier(0); \
        float mx = fmaxf(sc[0][0], sc[1][0]); \
        _Pragma("unroll") for (int r = 1; r < 16; ++r) mx = fmaxf(mx, fmaxf(sc[0][r], sc[1][r])); \
        { auto rr = __builtin_amdgcn_permlane32_swap(__float_as_uint(mx), __float_as_uint(mx), false, false); mx = fmaxf(__uint_as_float(rr[0]), __uint_as_float(rr[1])); } \
        if (__any(mx > mrun)) { const float mn = fmaxf(mrun, mx), alpha = __builtin_amdgcn_exp2f(mrun - mn); mrun = mn; lrun *= alpha; \
            _Pragma("unroll") for (int db = 0; db < 4; ++db) _Pragma("unroll") for (int r = 0; r < 16; ++r) o[db][r] *= alpha; } \
        float ls = 0.f; \
        _Pragma("unroll") for (int hf = 0; hf < 2; ++hf) _Pragma("unroll") for (int r = 0; r < 16; ++r) { const float pv = __builtin_amdgcn_exp2f(sc[hf][r] - mrun); sc[hf][r] = pv; ls += pv; } \
        lrun += ls; \
        _Pragma("unroll") for (int kk = 0; kk < 4; ++kk) { const int hf = kk >> 1, r0 = (kk & 1) * 8; u32x4 w; \
            w.x = cvt_pk_bf16(sc[hf][r0 + 0], sc[hf][r0 + 1]); w.y = cvt_pk_bf16(sc[hf][r0 + 2], sc[hf][r0 + 3]); w.z = cvt_pk_bf16(sc[hf][r0 + 4], sc[hf][r0 + 5]); w.w = cvt_pk_bf16(sc[hf][r0 + 6], sc[hf][r0 + 7]); \
            pf[kk] = __builtin_bit_cast(bf16x8, w); } } while (0)
#define ATT_PV(bofs) do { bf16x8 vfa[8], vfb[8]; \
        _Pragma("unroll") for (int kk = 0; kk < 2; ++kk) _Pragma("unroll") for (int db = 0; db < 4; ++db) vfa[kk * 4 + db] = *(const LAS bf16x8*)(lds + (vad[kk] + (bofs)) + KBUF + db * 4096); \
        asm volatile("s_waitcnt lgkmcnt(0)" ::: "memory"); __builtin_amdgcn_sched_barrier(0); \
        _Pragma("unroll") for (int kk = 0; kk < 2; ++kk) _Pragma("unroll") for (int db = 0; db < 4; ++db) vfb[kk * 4 + db] = *(const LAS bf16x8*)(lds + (vad[kk + 2] + (bofs)) + KBUF + db * 4096); \
        __builtin_amdgcn_sched_barrier(0); \
        _Pragma("unroll") for (int kk = 0; kk < 2; ++kk) _Pragma("unroll") for (int db = 0; db < 4; ++db) o[db] = __builtin_amdgcn_mfma_f32_32x32x16_bf16(vfa[kk * 4 + db], pf[kk], o[db], 0, 0, 0); \
        asm volatile("s_waitcnt lgkmcnt(0)" ::: "memory"); __builtin_amdgcn_sched_barrier(0); \
        _Pragma("unroll") for (int kk = 0; kk < 2; ++kk) _Pragma("unroll") for (int db = 0; db < 4; ++db) o[db] = __builtin_amdgcn_mfma_f32_32x32x16_bf16(vfb[kk * 4 + db], pf[kk + 2], o[db], 0, 0, 0); \
        __builtin_amdgcn_sched_barrier(0); } while (0)
    ATT_DMA(0, 0); ATT_DMA(1, BUF);
#pragma nounroll
    for (int j = 0; j < NT; ++j) {
        if (j + 1 < NT) asm volatile("s_waitcnt vmcnt(4) lgkmcnt(0)" ::: "memory"); else asm volatile("s_waitcnt vmcnt(0) lgkmcnt(0)" ::: "memory");
        __builtin_amdgcn_s_barrier(); asm volatile("" ::: "memory");
        if (j + 2 < NT) ATT_DMA(j + 2, ((j + 2) % 3) * BUF);
        if (j <= cq) { const int bo = (j % 3) * BUF; ATT_S(bo); ATT_PV(bo); }
    }
#undef ATT_DMA
#undef ATT_S
#undef ATT_PV
    float l; { auto rr = __builtin_amdgcn_permlane32_swap(__float_as_uint(lrun), __float_as_uint(lrun), false, false); l = __uint_as_float(rr[0]) + __uint_as_float(rr[1]); }
    LAS unsigned char* xp = lds + XOFF + rg * XPAIR;
    __syncthreads();
    if (s == 1) { const float sc2 = lam / l;
#pragma unroll
        for (int db = 0; db < 4; ++db)
#pragma unroll
            for (int rq = 0; rq < 4; ++rq) { f32x4 v = {o[db][4 * rq] * sc2, o[db][4 * rq + 1] * sc2, o[db][4 * rq + 2] * sc2, o[db][4 * rq + 3] * sc2};
                *(LAS f32x4*)(xp + r32 * XROW + (32 * db + 8 * rq + 4 * hi) * 4) = v; } }
    __syncthreads();
    if (s == 0) { const float i1 = 1.f / l; float ssq = 0.f;
#pragma unroll
        for (int db = 0; db < 4; ++db)
#pragma unroll
            for (int rq = 0; rq < 4; ++rq) { const f32x4 x = *(const LAS f32x4*)(xp + r32 * XROW + (32 * db + 8 * rq + 4 * hi) * 4);
#pragma unroll
                for (int k = 0; k < 4; ++k) { const float v = o[db][4 * rq + k] * i1 - x[k]; o[db][4 * rq + k] = v; ssq += v * v; } }
        { auto rr = __builtin_amdgcn_permlane32_swap(__float_as_uint(ssq), __float_as_uint(ssq), false, false); ssq = __uint_as_float(rr[0]) + __uint_as_float(rr[1]); }
        const float rn = rsqrtf(ssq * (1.0f / 128.0f) + EPS);
        asm volatile("s_waitcnt lgkmcnt(0)" ::: "memory");
#pragma unroll
        for (int db = 0; db < 4; ++db)
#pragma unroll
            for (int rq = 0; rq < 4; ++rq) { u32x2 w; w.x = cvt_pk_bf16(o[db][4 * rq] * rn, o[db][4 * rq + 1] * rn); w.y = cvt_pk_bf16(o[db][4 * rq + 2] * rn, o[db][4 * rq + 3] * rn);
                *(LAS u32x2*)(xp + r32 * OROW + (32 * db + 8 * rq + 4 * hi) * 2) = w; }
        asm volatile("s_waitcnt lgkmcnt(0)" ::: "memory");
        bf16_t* Ow = O + (tok0 + q0) * D + h * 128;
#pragma unroll
        for (int i = 0; i < 8; ++i) { const int idx = i * 64 + lane, row = idx >> 4, pc = idx & 15; const u32x4 v = *(const LAS u32x4*)(xp + row * OROW + pc * 16); gst16(Ow + (size_t)row * D + pc * 8, v); } }
    __syncthreads();
}
__device__ __forceinline__ void phase(const Ctx& F, const bf16_t* Q, const bf16_t* Kg, const bf16_t* VT, bf16_t* O, float lam) {
    for (int v = F.bid; v < 256; v += F.G) {
        const int xcd = v & 7, ci = v >> 3;
#pragma nounroll
        for (int i = 0; i < 8; ++i) { const int bh = xcd * 16 + (i >> 1) * 4 + (ci >> 3), p = ci & 7; const int qb = (i & 1) ? 15 - p : p; unit(F, bh >> 3, bh & 7, qb, Q, Kg, VT, O, lam); }
    }
}
}

__device__ __forceinline__ void pool_prep(const Ctx& F, const bf16_t* xb, const float* ss, bf16_t* P) {
    LAS float* rl = (LAS float*)F.lds;
    for (int blk = F.bid; blk < T / 128; blk += F.G) {
        const int tb = blk * 128;
        __syncthreads();
        if (F.tid < 144) { const int t = tb - 16 + F.tid; rl[F.tid] = t >= 0 ? rstd_of(ss, t) : 0.f; }
        __syncthreads();
        const int cg8 = F.tid & 127, sg = F.tid >> 7, c0 = cg8 * 8, g = c0 >> 8, w = 2 << g; const int t0 = tb + sg * 32, pos0 = t0 & (SEQ - 1);
        float sum[8];
#pragma unroll
        for (int k = 0; k < 8; ++k) sum[k] = 0.f;
        const int hstart = pos0 == 0 ? 0 : -(w - 1);
        for (int dt = hstart; dt < 0; ++dt) { const float r = rl[sg * 32 + 16 + dt]; const u32x4 v = gld16(xb + (size_t)(t0 + dt) * D + c0);
            sum[0] += bflo(v.x) * r; sum[1] += bfhi(v.x) * r; sum[2] += bflo(v.y) * r; sum[3] += bfhi(v.y) * r; sum[4] += bflo(v.z) * r; sum[5] += bfhi(v.z) * r; sum[6] += bflo(v.w) * r; sum[7] += bfhi(v.w) * r; }
#pragma nounroll
        for (int d4 = 0; d4 < 32; d4 += 4) {
            u32x4 vc[4], vo[4];
#pragma unroll
            for (int q = 0; q < 4; ++q) { const int dt = d4 + q; vc[q] = gld16(xb + (size_t)(t0 + dt) * D + c0); const int to = dt - w; vo[q] = gld16(xb + (size_t)(t0 + (to >= hstart ? to : dt)) * D + c0); }
#pragma unroll
            for (int q = 0; q < 4; ++q) { const int dt = d4 + q, pos = pos0 + dt; const float r = rl[sg * 32 + 16 + dt];
                float xv[8] = {bflo(vc[q].x) * r, bfhi(vc[q].x) * r, bflo(vc[q].y) * r, bfhi(vc[q].y) * r, bflo(vc[q].z) * r, bfhi(vc[q].z) * r, bflo(vc[q].w) * r, bfhi(vc[q].w) * r};
#pragma unroll
                for (int k = 0; k < 8; ++k) sum[k] += xv[k];
                if (dt - w >= hstart) { const float ro = rl[sg * 32 + 16 + dt - w];
                    sum[0] -= bflo(vo[q].x) * ro; sum[1] -= bfhi(vo[q].x) * ro; sum[2] -= bflo(vo[q].y) * ro; sum[3] -= bfhi(vo[q].y) * ro; sum[4] -= bflo(vo[q].z) * ro; sum[5] -= bfhi(vo[q].z) * ro; sum[6] -= bflo(vo[q].w) * ro; sum[7] -= bfhi(vo[q].w) * ro; }
                const float inv = 1.f / (float)(pos + 1 < w ? pos + 1 : w); u32x4 ow;
                ow.x = cvt_pk_bf16(sum[0] * inv - xv[0], sum[1] * inv - xv[1]); ow.y = cvt_pk_bf16(sum[2] * inv - xv[2], sum[3] * inv - xv[3]);
                ow.z = cvt_pk_bf16(sum[4] * inv - xv[4], sum[5] * inv - xv[5]); ow.w = cvt_pk_bf16(sum[6] * inv - xv[6], sum[7] * inv - xv[7]);
                gst16(P + ((size_t)g * T + t0 + dt) * 256 + (c0 & 255), ow); }
        }
    }
    __syncthreads();
}

__device__ __forceinline__ void final_norm(const Ctx& F, float* out, const bf16_t* xb, const float* ss, const float* gfin) {
    const int gw = F.bid * 8 + F.wave, NGW = F.G * 8;
    for (int m = gw; m < T; m += NGW) { const float rs = rstd_of(ss, m); g_f32x4* orow = (g_f32x4*)(out + (size_t)m * D) + F.lane; const g_u32x2* xr = (const g_u32x2*)(xb + (size_t)m * D) + F.lane; const g_f32x4* gr = (const g_f32x4*)gfin + F.lane;
        u32x2 w[4]; f32x4 g[4];
#pragma unroll
        for (int j = 0; j < 4; ++j) { w[j] = xr[64 * j]; g[j] = gr[64 * j]; }
#pragma unroll
        for (int j = 0; j < 4; ++j) { f32x4 v = {bflo(w[j].x) * rs * g[j][0], bfhi(w[j].x) * rs * g[j][1], bflo(w[j].y) * rs * g[j][2], bfhi(w[j].y) * rs * g[j][3]}; orow[64 * j] = v; } }
}

enum { PH_PRO = 0,
       PH_L0_U, PH_L0_SST, PH_L0_SOUT, PH_L0_GATE, PH_L0_OUT, PH_L0_UP, PH_L0_DOWN,
       PH_L1_QKV, PH_L1_VT, PH_L1_ATT, PH_L1_WO, PH_L1_UP, PH_L1_DOWN,
       PH_L2_PREP, PH_L2_POOL, PH_L2_UP, PH_L2_DOWN,
       PH_L3_U, PH_L3_SST, PH_L3_SOUT, PH_L3_GATE, PH_L3_OUT, PH_L3_UP, PH_L3_DOWN,
       PH_FIN, PH_COUNT };

__global__ void __launch_bounds__(512, 2) fwd_kernel(Args args) {
    extern __shared__ __attribute__((aligned(16))) unsigned char lds_raw[];
    Ctx F; F.lds = (LAS unsigned char*)lds_raw; F.a = &args;
    volatile LAS unsigned* bst = (volatile LAS unsigned*)(F.lds + 140032);
    if (threadIdx.x < 4) bst[threadIdx.x] = 0u;
    __syncthreads();
    XcdBarrier xbar = xcd_barrier_post((unsigned*)(args.ws + WS_BAR), bst);
    for (int phx = args.ph_lo * 2; phx < args.ph_hi * 2; ++phx) {
        const int ph = phx >> 1; if ((phx & 1) && !((REP_MASK >> ph) & 1ull)) continue;
        { int tid = threadIdx.x; asm volatile("" : "+v"(tid)); F.tid = tid; F.lane = tid & 63; F.wave = __builtin_amdgcn_readfirstlane(tid >> 6);
          int bid = blockIdx.x, G = gridDim.x; asm volatile("" : "+s"(bid), "+s"(G)); F.bid = bid; F.G = G; }
        unsigned char* ws = args.ws; asm volatile("" : "+s"(ws));
        float* stats = (float*)(ws + WS_STATS); bf16_t* xb = (bf16_t*)(ws + WS_XB); unsigned char* R = ws + WS_R;
        int layer = -1, sub = -1;
        if (ph >= PH_L0_U && ph <= PH_L0_DOWN) { layer = 0; const int k = ph - PH_L0_U; sub = k == 0 ? 0 : k == 1 ? 12 : k == 2 ? 14 : k - 1; }
        else if (ph >= PH_L1_QKV && ph <= PH_L1_DOWN) { layer = 1; const int k = ph - PH_L1_QKV; sub = k == 0 ? 6 : k == 1 ? 11 : k == 2 ? 7 : k == 3 ? 8 : k == 4 ? 4 : 5; }
        else if (ph >= PH_L2_PREP && ph <= PH_L2_DOWN) { layer = 2; const int k = ph - PH_L2_PREP; sub = k == 0 ? 9 : k == 1 ? 10 : k == 2 ? 4 : 5; }
        else if (ph >= PH_L3_U && ph <= PH_L3_DOWN) { layer = 3; const int k = ph - PH_L3_U; sub = k == 0 ? 0 : k == 1 ? 12 : k == 2 ? 14 : k - 1; }
        const int j = layer == 3 ? 1 : 0;
        const float* ss_mix = stats;
        const float* ss_mlp = stats + (size_t)16 * T;
        float* ss_next = stats;

        if (ph == PH_PRO) { if (EN(20)) prologue(F); }
        else if (ph == PH_FIN) { if (EN(21)) final_norm(F, args.out, xb, stats, args.in[I_NFIN]); }
        else if (sub == 0 && EN(0)) {
            pg8::Order S; S.init_std(T, D, F.G, F.bid);
            pg8::EpiScaleBf16<0, 1> E{(bf16_t*)R, (size_t)D, ss_mix};
            pg8::gemm_phase(F.tid, F.lds, pg8::mk_opnd(xb, D), pg8::mk_opnd(ws + WS_WIN + (size_t)j * 2 * MiB, D), D, S, E);
        } else if (sub == 12 && EN(12)) {
            pg8::EpiScan E{(bf16_t*)(R + 64 * MiB), (const f32x4*)(ws + WS_APW) + j * 4096};
#pragma nounroll
            for (int L = F.bid; L < 256; L += F.G) {
                pg8::Order S; S.init_grp(256, 4, 0, 0, 1 << 20, L);
                pg8::gemm_phase(F.tid, F.lds, pg8::mk_opnd(R, 512), pg8::mk_opnd(ws + WS_WST + (size_t)j * 16 * MiB, 512), 512, S, E); }
        } else if (sub == 14 && EN(14)) {
            pg8::Order S; S.init_grp(512, 8, 0, 0, F.G, F.bid);
            pg8::Opnd oa = pg8::mk_opnd(R, 256); oa.base2 = (const char*)(R + 64 * MiB);
            pg8::EpiSsmOut E{(const bf16_t*)R, (bf16_t*)(R + 192 * MiB), args.in[I_S5D] + j * D};
            pg8::gemm_phase<pg8::EpiSsmOut, 128, 4>(F.tid, F.lds, oa, pg8::mk_opnd(ws + WS_WSO + (size_t)j * 12 * MiB, 384), 384, S, E);
        } else if (sub == 2 && EN(2)) {
            pg8::Order S; S.init_std(T, D, F.G, F.bid);
            pg8::Opnd oa; oa.base = (const char*)(R + 192 * MiB); oa.base2 = oa.base; oa.tstep = 8192; oa.hstep = 4096; oa.rowB = 32; oa.c16B = (unsigned)T * 32u;
            pg8::EpiGate<1> E{(const bf16_t*)(R + 192 * MiB), (bf16_t*)R};
            pg8::gemm_phase<pg8::EpiGate<1>, (size_t)4 * T * 32>(F.tid, F.lds, oa, pg8::mk_opnd(ws + WS_WGATE + (size_t)j * 2 * MiB, D), D, S, E);
        } else if ((sub == 3 || sub == 8 || sub == 5 || sub == 10) && EN(3)) {
            pg8::Order S; if (sub == 10) S.init_grp(512, 128, 128, 1, F.G, F.bid); else S.init_std(T, D, F.G, F.bid);
            const unsigned char* Aop = sub == 8 ? R + 192 * MiB : R;
            const unsigned char* Bop = sub == 3 ? ws + WS_WOUT + (size_t)j * 2 * MiB : sub == 8 ? ws + WS_WO : sub == 10 ? ws + WS_WPOOL : ws + WS_W2 + (size_t)layer * 8 * MiB;
            const int K = sub == 5 ? FF : sub == 10 ? 256 : D;
            pg8::EpiRes E{xb, sub == 5 ? ss_next : (float*)ss_mlp};
            if (sub == 5) pg8::gemm_phase<pg8::EpiRes, 128, 0, true, true, true>(F.tid, F.lds, pg8::mk_opnd(Aop, K), pg8::mk_opnd(Bop, K), K, S, E);
            else pg8::gemm_phase(F.tid, F.lds, pg8::mk_opnd(Aop, K), pg8::mk_opnd(Bop, K), K, S, E);
        } else if (sub == 4 && EN(4)) {
            pg8::Order S; S.init_std(T, FF, F.G, F.bid);
            pg8::EpiScaleBf16<1, 0> E{(bf16_t*)R, (size_t)FF, ss_mlp};
            pg8::gemm_phase(F.tid, F.lds, pg8::mk_opnd(xb, D), pg8::mk_opnd(ws + WS_W1 + (size_t)layer * 8 * MiB, D), D, S, E);
        } else if (sub == 6 && EN(6)) {
            pg8::Order S; S.init_std(T, 2 * D, F.G, F.bid);
            pg8::EpiQK E{(bf16_t*)R, (bf16_t*)(R + 64 * MiB), ss_mix, (const float*)(ws + WS_ROPE), (const float*)(ws + WS_ROPE) + SEQ * 32, QSCALE};
            pg8::gemm_phase(F.tid, F.lds, pg8::mk_opnd(xb, D), pg8::mk_opnd(ws + WS_WQK, D), D, S, E);
        } else if (sub == 11 && EN(11)) {
            pg8::Order S; S.init_std(D, T, F.G, F.bid);
            pg8::EpiVT E{(bf16_t*)(R + 128 * MiB), ss_mix, F.lds + 131072};
            pg8::gemm_phase(F.tid, F.lds, pg8::mk_opnd(ws + WS_WV, D), pg8::mk_opnd(xb, D), D, S, E);
        } else if (sub == 7 && EN(7)) {
#ifndef NO_ATT
            att::phase(F, (const bf16_t*)R, (const bf16_t*)(R + 64 * MiB), (const bf16_t*)(R + 128 * MiB), (bf16_t*)(R + 192 * MiB), ((const float*)(ws + WS_MISC))[0]);
#endif
        } else if (sub == 9 && EN(9)) {
            pool_prep(F, xb, ss_mix, (bf16_t*)R);
        }
        if (phx + 1 < args.ph_hi * 2 && !(ph == PH_L1_QKV && args.ph_hi - args.ph_lo > 1)) { if (args.ph_hi > 4096) cg::this_grid().sync(); xcd_barrier(xbar); }
    }
}

extern "C" void kernel_launch(void* const* d_in, const int* in_sizes, int n_in, void* d_out, int out_size, void* d_ws, size_t ws_size, hipStream_t stream) {
    static int grid = 0;
    if (grid == 0) {
        if (n_in != 26 || out_size != T * D || ws_size < WS_END) { fprintf(stderr, "kernel_launch: unexpected problem (n_in %d out %d ws %zu)\n", n_in, out_size, ws_size); grid = -1; return; }
        int dev = 0, cus = 0, per_cu = 0;
        (void)hipGetDevice(&dev); (void)hipDeviceGetAttribute(&cus, hipDeviceAttributeMultiprocessorCount, dev);
        (void)hipFuncSetAttribute((const void*)fwd_kernel, hipFuncAttributeMaxDynamicSharedMemorySize, LDS_BYTES);
        (void)hipOccupancyMaxActiveBlocksPerMultiprocessor(&per_cu, (const void*)fwd_kernel, 512, LDS_BYTES);
        if (per_cu < 1) { fprintf(stderr, "kernel_launch: occupancy query says %d blocks per CU\n", per_cu); per_cu = 1; }
        (void)hipGetLastError();
        grid = cus * 1;
    }
    if (grid < 0) return;
    Args a{};
    for (int i = 0; i < 26; ++i) a.in[i] = (const float*)d_in[i];
    a.out = (float*)d_out; a.ws = (unsigned char*)d_ws;
    (void)hipMemsetAsync((unsigned char*)d_ws + WS_BAR, 0, XCD_BAR_WORDS * 4, stream);
#if ONE_LAUNCH
    a.ph_lo = 0; a.ph_hi = PH_COUNT;
    void* kargs[] = {&a};
    hipError_t e = hipLaunchCooperativeKernel((const void*)fwd_kernel, dim3(grid), dim3(512), kargs, LDS_BYTES, stream);
    if (e != hipSuccess) fprintf(stderr, "cooperative launch failed: %s (grid %d)\n", hipGetErrorString(e), grid);
#else
    for (int ph = 0; ph < PH_COUNT; ++ph) { a.ph_lo = ph; a.ph_hi = ph + 1; hipLaunchKernelGGL(fwd_kernel, dim3(grid), dim3(512), LDS_BYTES, stream, a); }
#endif
}
```

```cpp
#include <hip/hip_runtime.h>
#include <hip/hip_cooperative_groups.h>
#include <cstdio>
#include <cstdint>
namespace cg = cooperative_groups;

#ifndef ONE_LAUNCH
#define ONE_LAUNCH 1
#endif
#ifndef ONLY_SUB
#define ONLY_SUB -1
#endif
#ifndef DIS_SUB
#define DIS_SUB -2
#endif
#define EN(x) ((ONLY_SUB < 0 || ONLY_SUB == (x)) && (x) != DIS_SUB)
#ifndef REP_MASK
#define REP_MASK 0ull
#endif
#ifndef SSM_GEMM
#define SSM_GEMM 1
#endif

#define LAS __attribute__((address_space(3)))
typedef unsigned short bf16_t;
typedef short bf16x8 __attribute__((ext_vector_type(8)));
typedef float f32x4 __attribute__((ext_vector_type(4)));
typedef float f32x16 __attribute__((ext_vector_type(16)));
typedef unsigned u32x4 __attribute__((ext_vector_type(4)));
typedef unsigned u32x2 __attribute__((ext_vector_type(2)));

constexpr int NB = 16, SEQ = 2048, T = NB * SEQ, D = 1024, FF = 4096;
constexpr float EPS = 1e-6f;
constexpr size_t MiB = 1u << 20;
constexpr size_t WS_STATS = 464 * MiB;
constexpr size_t WS_ROPE = 2 * MiB;
constexpr size_t WS_MISC = 2 * MiB + 512 * 1024;
constexpr size_t WS_WIN = 3 * MiB, WS_WGATE = 7 * MiB, WS_WOUT = 11 * MiB;
constexpr size_t WS_WQK = 15 * MiB;
constexpr size_t WS_WV = 19 * MiB;
constexpr size_t WS_WO = 21 * MiB;
constexpr size_t WS_WPOOL = 23 * MiB;
constexpr size_t WS_W1 = 24 * MiB, WS_W2 = 56 * MiB;
constexpr size_t WS_WST = 88 * MiB;
constexpr size_t WS_WSO = 120 * MiB;
constexpr size_t WS_XB = 144 * MiB;
constexpr size_t WS_R = 208 * MiB;
constexpr size_t WS_END = 468 * MiB;
constexpr size_t WS_RSD = WS_MISC + 65536;
constexpr size_t WS_BAR = WS_MISC + 409600;
constexpr size_t WS_XTAB = WS_MISC + 8192;
constexpr size_t WS_APW = WS_MISC + 262144;

__device__ __forceinline__ unsigned cvt_pk_bf16(float lo, float hi) { unsigned r; asm volatile("v_cvt_pk_bf16_f32 %0, %1, %2" : "=v"(r) : "v"(lo), "v"(hi)); return r; }
__device__ __forceinline__ float bf2f(unsigned short b) { return __uint_as_float(((unsigned)b) << 16); }
__device__ __forceinline__ float bflo(unsigned w) { return __uint_as_float(w << 16); }
__device__ __forceinline__ float bfhi(unsigned w) { return __uint_as_float(w & 0xffff0000u); }
__device__ __forceinline__ unsigned short f2bf(float f) { unsigned u = __float_as_uint(f); return (unsigned short)((u + 0x7fffu + ((u >> 16) & 1u)) >> 16); }
__device__ __forceinline__ float gelu_tanh(float y) { const float a = 1.5957691216f * (y + 0.044715f * y * y * y); return y / (1.f + __expf(-a)); }
__device__ __forceinline__ float sigmoidf_(float a) { return 1.f / (1.f + __expf(-a)); }
#define GAS __attribute__((address_space(1)))
typedef GAS u32x4 g_u32x4; typedef GAS u32x2 g_u32x2; typedef GAS f32x4 g_f32x4; typedef GAS float g_f32;
__device__ __forceinline__ u32x4 gld16(const void* p) { return *(const g_u32x4*)p; }
__device__ __forceinline__ f32x4 gldf4(const void* p) { return *(const g_f32x4*)p; }
__device__ __forceinline__ void gst16(void* p, u32x4 v) { *(g_u32x4*)p = v; }
__device__ __forceinline__ void gst16nt(void* p, u32x4 v) { __builtin_nontemporal_store(v, (g_u32x4*)p); }
__device__ __forceinline__ void gstf(void* p, float v) { *(g_f32*)p = v; }
__device__ __forceinline__ f32x4 gldf4nt(const void* p) { return __builtin_nontemporal_load((const g_f32x4*)p); }
__device__ __forceinline__ float red4(float s) {
    { auto rr = __builtin_amdgcn_permlane16_swap(__float_as_uint(s), __float_as_uint(s), false, false); s = __uint_as_float(rr[0]) + __uint_as_float(rr[1]); }
    { auto rr = __builtin_amdgcn_permlane32_swap(__float_as_uint(s), __float_as_uint(s), false, false); s = __uint_as_float(rr[0]) + __uint_as_float(rr[1]); }
    return s; }
__device__ __forceinline__ float rstd_of(const float* ss, int row) { const g_f32x4* p = (const g_f32x4*)(ss + (size_t)row * 16); const f32x4 a = p[0], b = p[1], c = p[2], d = p[3];
    const float s = ((a[0] + a[1]) + (a[2] + a[3])) + ((b[0] + b[1]) + (b[2] + b[3])) + (((c[0] + c[1]) + (c[2] + c[3])) + ((d[0] + d[1]) + (d[2] + d[3]))); return rsqrtf(s * (1.0f / 1024.0f) + EPS); }
__device__ __forceinline__ float rstd_epi(const float* ss, int row, int fq) { const f32x4 a = *(const f32x4*)(ss + (size_t)row * 16 + fq * 4); const float s = red4((a[0] + a[1]) + (a[2] + a[3])); return rsqrtf(s * (1.0f / 1024.0f) + EPS); }

namespace pg8 {
constexpr int BM = 256, BK = 64, HALF = 128, HTB = HALF * BK * 2, STAGE_BYTES = 8 * HTB, NXCD = 8, WGM = 8;
__host__ __device__ __forceinline__ int lds_byte(int r, int c) { const int st = (r >> 4) * 2 + (c >> 5), rr = r & 15, cc = c & 31, ob = rr * 64 + cc * 2; return st * 1024 + (ob ^ (((ob >> 9) & 1) << 5)); }
__host__ __device__ __forceinline__ void stage_rc(int b, int& R, int& C) { const int st = b / 1024, sb = b % 1024, swz = sb ^ (((sb >> 9) & 1) << 5); R = (st >> 1) * 16 + swz / 64; C = (st & 1) * 32 + (swz % 64) / 2; }
__host__ __device__ __forceinline__ int perm32(int rho) { const int n = rho >> 4, i = rho & 15; return 8 * (i >> 2) + 4 * n + (i & 3); }

struct Unit { int pm, pn, om, on; };
struct Opnd { const char* base; const char* base2; size_t tstep, hstep; unsigned rowB, c16B; };
__device__ __forceinline__ Opnd mk_opnd(const void* base, int K) { Opnd o; o.base = (const char*)base; o.base2 = o.base; o.rowB = (unsigned)K * 2u; o.tstep = (size_t)256 * o.rowB; o.hstep = (size_t)128 * o.rowB; o.c16B = 32; return o; }

struct Order {
    int mode, nM, nN, nwg, G, c, div, modm, onpn;
    __device__ void init_std(int M, int N, int G_, int c_) { mode = 0; nM = M / BM; nN = N / BM; nwg = nM * nN; G = G_; c = c_; div = 1; modm = 0; onpn = 0; }
    __device__ void init_grp(int nunits, int div_, int modm_, int onpn_, int G_, int c_) { mode = 1; nM = nunits; nN = 1; nwg = nunits; G = G_; c = c_; div = div_; modm = modm_; onpn = onpn_; }
    __device__ bool next(int i, Unit& u) const {
        const long L = (long)i * G + c; if (L >= nwg) return false;
        if (mode == 0) {
            int wgid = (int)L; { const int q = nwg / NXCD, r = nwg % NXCD, xcd = wgid % NXCD, off = wgid / NXCD; wgid = (xcd < r ? xcd * (q + 1) : r * (q + 1) + (xcd - r) * q) + off; }
            const int nig = WGM * nN, gid = wgid / nig, fm = gid * WGM, gsz = (nM - fm) < WGM ? (nM - fm) : WGM;
            u.pm = fm + ((wgid % nig) % gsz); u.pn = (wgid % nig) / gsz; u.om = u.pm; u.on = u.pn;
        } else {
            u.pm = (int)L; u.pn = (int)L / div; u.om = modm ? ((int)L % modm) : (int)L; u.on = onpn ? u.pn : 0;
        }
        return true;
    }
};

#define EPI_ARGS const f32x4 (&acc)[2][2][4][2], const Unit& u, int wr, int wc, int fr, int fq
__device__ __forceinline__ u32x4 pack8(f32x4 v0, f32x4 v1) { u32x4 w; w.x = cvt_pk_bf16(v0[0], v0[1]); w.y = cvt_pk_bf16(v0[2], v0[3]); w.z = cvt_pk_bf16(v1[0], v1[1]); w.w = cvt_pk_bf16(v1[2], v1[3]); return w; }

template <int ACT, int UMODE> struct EpiScaleBf16 {
    static constexpr bool PERM = true, AFTER_DRAIN = false;
    bf16_t* O; size_t ldc; const float* ss;
    __device__ __forceinline__ void operator()(EPI_ARGS) const {
        const int row0 = u.om * BM + wr * 64 + fr, col0 = u.on * BM + wc * 32 + 8 * fq;
        float rs[2][4];
        { f32x4 pa[2][4];
#pragma unroll
          for (int ai = 0; ai < 2; ++ai)
#pragma unroll
              for (int m = 0; m < 4; ++m) pa[ai][m] = gldf4(ss + (size_t)(row0 + ai * HALF + m * 16) * 16 + fq * 4);
#pragma unroll
          for (int ai = 0; ai < 2; ++ai)
#pragma unroll
              for (int m = 0; m < 4; ++m) rs[ai][m] = rsqrtf(red4((pa[ai][m][0] + pa[ai][m][1]) + (pa[ai][m][2] + pa[ai][m][3])) * (1.0f / 1024.0f) + EPS); }
#pragma unroll
        for (int ai = 0; ai < 2; ++ai)
#pragma unroll
            for (int m = 0; m < 4; ++m) { const int row = row0 + ai * HALF + m * 16; const float r = rs[ai][m];
#pragma unroll
                for (int bj = 0; bj < 2; ++bj) { f32x4 v0 = acc[ai][bj][m][0] * r, v1 = acc[ai][bj][m][1] * r;
                    if (ACT == 1) {
#pragma unroll
                        for (int j = 0; j < 4; ++j) { const float x = fmaxf(v0[j], 0.f), y = fmaxf(v1[j], 0.f); v0[j] = x * x; v1[j] = y * y; } }
                    const int c = col0 + bj * HALF;
                    if (UMODE == 0) { if (ACT == 1) gst16nt(O + (size_t)row * ldc + c, pack8(v0, v1)); else gst16(O + (size_t)row * ldc + c, pack8(v0, v1)); }
                    else { const int g = c >> 4, h0 = c & 15; gst16(O + ((size_t)(g * 2048 + (row >> 4)) * 256 + (row & 15) * 16 + h0), pack8(v0, v1)); } } }
    }
};
struct EpiF32 {
    static constexpr bool PERM = true, AFTER_DRAIN = false;
    float* C; size_t ldc;
    __device__ __forceinline__ void operator()(EPI_ARGS) const {
        const int row0 = u.om * BM + wr * 64 + fr, col0 = u.on * BM + wc * 32 + 8 * fq;
#pragma unroll
        for (int ai = 0; ai < 2; ++ai)
#pragma unroll
            for (int m = 0; m < 4; ++m) { float* rp = C + (size_t)(row0 + ai * HALF + m * 16) * ldc + col0;
#pragma unroll
                for (int bj = 0; bj < 2; ++bj) { *(f32x4*)(rp + bj * HALF) = acc[ai][bj][m][0]; *(f32x4*)(rp + bj * HALF + 4) = acc[ai][bj][m][1]; } }
    }
};
struct EpiScan {
    static constexpr bool PERM = true, AFTER_DRAIN = true;
    bf16_t* HB; const f32x4* APW;
    __device__ __forceinline__ void operator()(EPI_ARGS) const {}
    __device__ __forceinline__ void fused(EPI_ARGS, LAS unsigned char* lds, int tid) const {
        constexpr int PITCH = 260;
        LAS float* L = (LAS float*)lds; const int g = u.pn, rt = u.pm & 3;
#pragma unroll
        for (int ai = 0; ai < 2; ++ai) {
#pragma unroll
            for (int m = 0; m < 4; ++m)
#pragma unroll
                for (int bj = 0; bj < 2; ++bj) { LAS float* d = L + (wr * 64 + m * 16 + fr) * PITCH + bj * HALF + wc * 32 + 8 * fq; *(LAS f32x4*)d = acc[ai][bj][m][0]; *(LAS f32x4*)(d + 4) = acc[ai][bj][m][1]; }
            __syncthreads();
            if (tid < 128) { const int bb = tid >> 6, p = tid & 63, b = rt * 4 + ai * 2 + bb; const f32x4 aw = gldf4(APW + g * 64 + p);
                const LAS float* sp = L + (bb * 64) * PITCH + p; GAS bf16_t* hp = (GAS bf16_t*)(HB + ((size_t)g * 2048 + b * 128) * 256 + p);
                float hr = 0.f, hi = 0.f;
#pragma unroll 4
                for (int m = 0; m < 64; ++m) {
                    const float s16r = sp[m * PITCH], s16i = sp[m * PITCH + 64], s32r = sp[m * PITCH + 128], s32i = sp[m * PITCH + 192];
                    hp[(2 * m) * 256] = f2bf(hr); hp[(2 * m) * 256 + 64] = f2bf(hi);
                    const float h1r = aw[0] * hr - aw[1] * hi + s16r, h1i = aw[0] * hi + aw[1] * hr + s16i;
                    hp[(2 * m + 1) * 256] = f2bf(h1r); hp[(2 * m + 1) * 256 + 64] = f2bf(h1i);
                    const float nr = aw[2] * hr - aw[3] * hi + s32r, ni = aw[2] * hi + aw[3] * hr + s32i; hr = nr; hi = ni; } }
            __syncthreads();
        }
    }
};
template <int ZMODE> struct EpiGate {
    static constexpr bool PERM = true, AFTER_DRAIN = false;
    const bf16_t* Z; bf16_t* O;
    __device__ __forceinline__ const bf16_t* zaddr(int row, int c) const { return ZMODE == 0 ? Z + (size_t)row * D + c : Z + ((size_t)(c >> 4) * T + row) * 16 + (c & 15); }
    __device__ __forceinline__ void operator()(EPI_ARGS) const {
        const int row0 = u.om * BM + wr * 64 + fr, col0 = u.on * BM + wc * 32 + 8 * fq;
        u32x4 zn0 = gld16(zaddr(row0, col0)), zn1 = gld16(zaddr(row0, col0 + HALF));
#pragma unroll
        for (int idx = 0; idx < 8; ++idx) { const int ai = idx >> 2, m = idx & 3, row = row0 + ai * HALF + m * 16; const u32x4 zc[2] = {zn0, zn1};
            if (idx < 7) { const int rn = row0 + ((idx + 1) >> 2) * HALF + ((idx + 1) & 3) * 16; zn0 = gld16(zaddr(rn, col0)); zn1 = gld16(zaddr(rn, col0 + HALF)); }
#pragma unroll
            for (int bj = 0; bj < 2; ++bj) { const int c = col0 + bj * HALF; const u32x4 zw = zc[bj];
                f32x4 v0 = acc[ai][bj][m][0], v1 = acc[ai][bj][m][1];
                v0[0] = bflo(zw.x) * sigmoidf_(v0[0]); v0[1] = bfhi(zw.x) * sigmoidf_(v0[1]); v0[2] = bflo(zw.y) * sigmoidf_(v0[2]); v0[3] = bfhi(zw.y) * sigmoidf_(v0[3]);
                v1[0] = bflo(zw.z) * sigmoidf_(v1[0]); v1[1] = bfhi(zw.z) * sigmoidf_(v1[1]); v1[2] = bflo(zw.w) * sigmoidf_(v1[2]); v1[3] = bfhi(zw.w) * sigmoidf_(v1[3]);
                gst16(O + (size_t)row * D + c, pack8(v0, v1)); } }
    }
};
struct EpiRes {
    static constexpr bool PERM = true, AFTER_DRAIN = false;
    bf16_t* xb; float* ssn;
    __device__ __forceinline__ void operator()(EPI_ARGS) const {
        const int row0 = u.om * BM + wr * 64 + fr, col0 = u.on * BM + wc * 32 + 8 * fq;
        u32x4 xn0 = gld16(xb + (size_t)row0 * D + col0), xn1 = gld16(xb + (size_t)row0 * D + col0 + HALF);
#pragma unroll
        for (int idx = 0; idx < 8; ++idx) { const int ai = idx >> 2, m = idx & 3, row = row0 + ai * HALF + m * 16; const u32x4 xc[2] = {xn0, xn1}; float sq = 0.f;
            if (idx < 7) { const int rn = row0 + ((idx + 1) >> 2) * HALF + ((idx + 1) & 3) * 16; xn0 = gld16(xb + (size_t)rn * D + col0); xn1 = gld16(xb + (size_t)rn * D + col0 + HALF); }
#pragma unroll
            for (int bj = 0; bj < 2; ++bj) { const size_t off = (size_t)row * D + col0 + bj * HALF; const u32x4 xo = xc[bj];
                f32x4 v0 = acc[ai][bj][m][0], v1 = acc[ai][bj][m][1];
                v0[0] += bflo(xo.x); v0[1] += bfhi(xo.x); v0[2] += bflo(xo.y); v0[3] += bfhi(xo.y); v1[0] += bflo(xo.z); v1[1] += bfhi(xo.z); v1[2] += bflo(xo.w); v1[3] += bfhi(xo.w);
                const u32x4 w = pack8(v0, v1); gst16(xb + off, w);
                const float r0 = bflo(w.x), r1 = bfhi(w.x), r2 = bflo(w.y), r3 = bfhi(w.y), r4 = bflo(w.z), r5 = bfhi(w.z), r6 = bflo(w.w), r7 = bfhi(w.w);
                sq += (r0 * r0 + r1 * r1) + (r2 * r2 + r3 * r3) + (r4 * r4 + r5 * r5) + (r6 * r6 + r7 * r7); }
            sq = red4(sq);
            if (fq == 0) gstf(ssn + (size_t)row * 16 + u.on * 4 + wc, sq); }
    }
};
struct EpiQK {
    static constexpr bool PERM = true, AFTER_DRAIN = false;
    bf16_t* Q; bf16_t* Kq; const float* ss; const float* ropec; const float* ropes; float qscale;
    __device__ __forceinline__ void operator()(EPI_ARGS) const {
        const int row0 = u.om * BM + wr * 64 + fr; const int isk = u.on >> 2, t4 = u.on & 3;
        bf16_t* base = isk ? Kq : Q; const float sc = isk ? 1.f : qscale;
        const int colf = t4 * 256 + wc * 64 + 8 * fq;
        float rs[8];
        { f32x4 pa[8];
#pragma unroll
          for (int idx = 0; idx < 8; ++idx) pa[idx] = gldf4(ss + (size_t)(row0 + (idx >> 2) * HALF + (idx & 3) * 16) * 16 + fq * 4);
#pragma unroll
          for (int idx = 0; idx < 8; ++idx) rs[idx] = rsqrtf(red4((pa[idx][0] + pa[idx][1]) + (pa[idx][2] + pa[idx][3])) * (1.0f / 1024.0f) + EPS) * sc; }
        const int p0 = (row0 & (SEQ - 1)) * 32 + 8 * fq;
        f32x4 cn0 = gldf4(ropec + p0), cn1 = gldf4(ropec + p0 + 4), sn0 = gldf4(ropes + p0), sn1 = gldf4(ropes + p0 + 4);
#pragma unroll
        for (int idx = 0; idx < 8; ++idx) { const int ai = idx >> 2, m = idx & 3, row = row0 + ai * HALF + m * 16; const float r = rs[idx];
            const f32x4 c0 = cn0, c1 = cn1, s0 = sn0, s1 = sn1;
            if (idx < 7) { const int rn = row0 + ((idx + 1) >> 2) * HALF + ((idx + 1) & 3) * 16, pn = (rn & (SEQ - 1)) * 32 + 8 * fq; cn0 = gldf4(ropec + pn); cn1 = gldf4(ropec + pn + 4); sn0 = gldf4(ropes + pn); sn1 = gldf4(ropes + pn + 4); }
            const f32x4 a0 = acc[ai][0][m][0] * r, a1 = acc[ai][0][m][1] * r, b0 = acc[ai][1][m][0] * r, b1 = acc[ai][1][m][1] * r;
            const f32x4 o0 = a0 * c0 - b0 * s0, o1 = a1 * c1 - b1 * s1, q0 = b0 * c0 + a0 * s0, q1 = b1 * c1 + a1 * s1;
            gst16(base + (size_t)row * D + colf, pack8(o0, o1)); gst16(base + (size_t)row * D + colf + 32, pack8(q0, q1)); }
    }
};
struct EpiVT {
    static constexpr bool PERM = true, AFTER_DRAIN = false;
    bf16_t* O; const float* ss; LAS unsigned char* ldsx;
    __device__ __forceinline__ void operator()(EPI_ARGS) const {
        const int row0 = u.om * BM + wr * 64 + fr, col0 = u.on * BM + wc * 32 + 8 * fq; const int lane = fq * 16 + fr;
        LAS float* tb = (LAS float*)(ldsx + (wr * 4 + wc) * 256);
        tb[lane] = rstd_of(ss, u.on * BM + wc * 32 + 128 * (lane >> 5) + (lane & 31));
        asm volatile("s_waitcnt lgkmcnt(0)" ::: "memory");
#pragma unroll
        for (int bj = 0; bj < 2; ++bj) { const int c = col0 + bj * HALF; const f32x4 r0 = *(const LAS f32x4*)(tb + bj * 32 + 8 * fq), r1 = *(const LAS f32x4*)(tb + bj * 32 + 8 * fq + 4);
#pragma unroll
            for (int ai = 0; ai < 2; ++ai)
#pragma unroll
                for (int m = 0; m < 4; ++m) { const int row = row0 + ai * HALF + m * 16; gst16(O + (size_t)row * T + c, pack8(acc[ai][bj][m][0] * r0, acc[ai][bj][m][1] * r1)); } }
    }
};
struct EpiSsmOut {
    static constexpr bool PERM = true, AFTER_DRAIN = false;
    const bf16_t* AUG; bf16_t* Z; const float* dsk;
    __device__ __forceinline__ void operator()(EPI_ARGS) const {
        const int row0 = u.om * BM + wr * 64 + fr, col0 = wc * 32 + 8 * fq; const int g = u.pn;
        const f32x4 d0 = gldf4(dsk + g * 16 + (col0 & 15)), d1 = gldf4(dsk + g * 16 + (col0 & 15) + 4);
        u32x4 un0 = gld16(AUG + (size_t)row0 * 256 + col0), un1 = gld16(AUG + (size_t)row0 * 256 + col0 + HALF);
#pragma unroll
        for (int idx = 0; idx < 8; ++idx) { const int ai = idx >> 2, m = idx & 3, row = row0 + ai * HALF + m * 16; const u32x4 uc[2] = {un0, un1};
            if (idx < 7) { const int rn = row0 + ((idx + 1) >> 2) * HALF + ((idx + 1) & 3) * 16; un0 = gld16(AUG + (size_t)rn * 256 + col0); un1 = gld16(AUG + (size_t)rn * 256 + col0 + HALF); }
#pragma unroll
            for (int bj = 0; bj < 2; ++bj) { const int c = col0 + bj * HALF; const u32x4 uw = uc[bj];
                f32x4 v0 = acc[ai][bj][m][0], v1 = acc[ai][bj][m][1];
                v0[0] = gelu_tanh(v0[0] + d0[0] * bflo(uw.x)); v0[1] = gelu_tanh(v0[1] + d0[1] * bfhi(uw.x)); v0[2] = gelu_tanh(v0[2] + d0[2] * bflo(uw.y)); v0[3] = gelu_tanh(v0[3] + d0[3] * bfhi(uw.y));
                v1[0] = gelu_tanh(v1[0] + d1[0] * bflo(uw.z)); v1[1] = gelu_tanh(v1[1] + d1[1] * bfhi(uw.z)); v1[2] = gelu_tanh(v1[2] + d1[2] * bflo(uw.w)); v1[3] = gelu_tanh(v1[3] + d1[3] * bfhi(uw.w));
                gst16(Z + (size_t)row * 256 + c, pack8(v0, v1)); } }
    }
};

template <class Epi, size_t KSA = 128, int KSPLIT = 0, bool ALIGN_EPI = true, bool SP2 = true>
__device__ __forceinline__ void gemm_phase(const int tid, LAS unsigned char* lds, const Opnd oa, const Opnd ob, const int K, const Order& S, const Epi& E) {
    const int wid = __builtin_amdgcn_readfirstlane(tid >> 6), lane = tid & 63, wr = wid >> 2, wc = wid & 3, fr = lane & 15, fq = lane >> 4;
    const int nt = K / BK;
    unsigned voffA[2], voffB[2];
#pragma unroll
    for (int i = 0; i < 2; ++i) { int R, C; stage_rc(tid * 16 + i * 8192, R, C); const int Rb = Epi::PERM ? ((R & ~31) + perm32(R & 31)) : R;
        voffA[i] = (unsigned)R * oa.rowB + (unsigned)(C >> 4) * oa.c16B + (unsigned)(C & 15) * 2u; voffB[i] = (unsigned)Rb * ob.rowB + (unsigned)(C >> 4) * ob.c16B + (unsigned)(C & 15) * 2u; }
    const size_t hA = oa.hstep, hB = ob.hstep;
    const unsigned ldsw = (unsigned)wid * 1024u;
    const int aoff = lds_byte(wr * 64 + fr, fq * 8), boff = lds_byte(wc * 32 + fr, fq * 8);
#define PG8_SA(b, h) (((b) * 2 + (h)) * HTB)
#define PG8_SB(b, h) ((4 + (b) * 2 + (h)) * HTB)
#define PG8_STAGE(bufoff, gbase, voff) do { _Pragma("unroll") for (int _i = 0; _i < 2; ++_i) \
        __builtin_amdgcn_global_load_lds((const unsigned*)((const char*)(gbase) + (voff)[_i]), (LAS unsigned*)(lds + (bufoff) + ldsw + _i * 8192), 16, 0, 0); } while (0)
#define PG8_LDA(dst, b, h) do { _Pragma("unroll") for (int m = 0; m < 4; ++m) _Pragma("unroll") for (int k = 0; k < 2; ++k) dst[m][k] = *(const LAS bf16x8*)(lds + PG8_SA(b, h) + aoff + m * 2048 + k * 1024); } while (0)
#define PG8_LDB(dst, b, h) do { _Pragma("unroll") for (int n = 0; n < 2; ++n) _Pragma("unroll") for (int k = 0; k < 2; ++k) dst[n][k] = *(const LAS bf16x8*)(lds + PG8_SB(b, h) + boff + n * 2048 + k * 1024); } while (0)
#define PG8_MMA(ai, bj, At, Bt) do { __builtin_amdgcn_s_setprio(1); _Pragma("unroll") for (int m = 0; m < 4; ++m) _Pragma("unroll") for (int n = 0; n < 2; ++n) _Pragma("unroll") for (int k = 0; k < 2; ++k) \
        acc[ai][bj][m][n] = __builtin_amdgcn_mfma_f32_16x16x32_bf16(Bt[n][k], At[m][k], acc[ai][bj][m][n], 0, 0, 0); __builtin_amdgcn_s_setprio(0); } while (0)
#define PG8_WAIT_V(n) asm volatile("s_waitcnt vmcnt(" #n ")" ::: "memory")
#define PG8_WAIT_L(n) asm volatile("s_waitcnt lgkmcnt(" #n ")" ::: "memory")
#define PG8_BAR __builtin_amdgcn_s_barrier()
#define PG8_SCHED __builtin_amdgcn_sched_barrier(0)
    Unit cur, nxt; int ui = 0;
    if (!S.next(0, cur)) return;
    f32x4 acc[2][2][4][2];
#pragma unroll
    for (int a = 0; a < 2; ++a)
#pragma unroll
        for (int b = 0; b < 2; ++b)
#pragma unroll
            for (int m = 0; m < 4; ++m)
#pragma unroll
                for (int n = 0; n < 2; ++n) acc[a][b][m][n] = (f32x4){0.f, 0.f, 0.f, 0.f};
    bf16x8 At[4][2], B0[2][2], B1[2][2];
    const char* cA = oa.base + (size_t)cur.pm * oa.tstep; const char* cB = ob.base + (size_t)cur.pn * ob.tstep; const char* cA2 = oa.base2 + (size_t)cur.pm * oa.tstep;
    constexpr size_t kA1 = KSA, kB1 = 128;
#define PG8_ATILE(c, c2, t) ((KSPLIT > 0 && (t) >= KSPLIT) ? (c2) + (size_t)((t) - KSPLIT) * KSA : (c) + (size_t)(t) * KSA)
    if constexpr (SP2) {
        PG8_STAGE(PG8_SB(0, 0), cB, voffB); PG8_STAGE(PG8_SB(0, 1), cB + hB, voffB); PG8_STAGE(PG8_SA(0, 0), cA, voffA); PG8_STAGE(PG8_SA(0, 1), cA + hA, voffA);
        if (wr == 1) PG8_BAR;
        PG8_WAIT_V(2); PG8_BAR;
        PG8_STAGE(PG8_SB(1, 0), cB + kB1, voffB); PG8_STAGE(PG8_SA(1, 0), cA + kA1, voffA); PG8_STAGE(PG8_SB(1, 1), cB + hB + kB1, voffB);
        PG8_WAIT_V(6); PG8_BAR;
    } else {
        PG8_STAGE(PG8_SB(0, 0), cB, voffB); PG8_STAGE(PG8_SA(0, 0), cA, voffA); PG8_STAGE(PG8_SB(0, 1), cB + hB, voffB); PG8_STAGE(PG8_SA(0, 1), cA + hA, voffA);
        if (wr == 1) PG8_BAR;
        PG8_WAIT_V(4); PG8_BAR;
        PG8_STAGE(PG8_SB(1, 0), cB + kB1, voffB); PG8_STAGE(PG8_SA(1, 0), cA + kA1, voffA); PG8_STAGE(PG8_SB(1, 1), cB + hB + kB1, voffB);
        PG8_WAIT_V(6); PG8_BAR;
    }
    for (;;) {
        const bool has_next = S.next(ui + 1, nxt);
        const char* nA = has_next ? oa.base + (size_t)nxt.pm * oa.tstep : cA; const char* nA2 = has_next ? oa.base2 + (size_t)nxt.pm * oa.tstep : cA2; const char* nB = has_next ? ob.base + (size_t)nxt.pn * ob.tstep : cB;
#pragma nounroll
        for (int t = 0; t < nt; t += 2) {
            const bool last = (t == nt - 2);
            const char* a1 = PG8_ATILE(cA, cA2, t + 1);
            const char* a2 = last ? nA : PG8_ATILE(cA, cA2, t + 2); const char* b2 = last ? nB : cB + (size_t)(t + 2) * 128;
            const char* a3 = last ? nA + kA1 : PG8_ATILE(cA, cA2, t + 3); const char* b3 = b2 + kB1;
            if constexpr (SP2) {
            PG8_LDB(B0, 0, 0); PG8_LDB(B1, 0, 1); PG8_SCHED; PG8_LDA(At, 0, 0); PG8_STAGE(PG8_SA(1, 1), a1 + hA, voffA);
            PG8_WAIT_V(8); PG8_WAIT_L(0); PG8_BAR; PG8_MMA(0, 0, At, B0); PG8_MMA(0, 1, At, B1); PG8_BAR; PG8_SCHED;
            PG8_LDA(At, 0, 1); PG8_STAGE(PG8_SB(0, 0), b2, voffB); PG8_STAGE(PG8_SB(0, 1), b2 + hB, voffB); PG8_STAGE(PG8_SA(0, 0), a2, voffA);
            PG8_WAIT_V(8); PG8_WAIT_L(0); PG8_BAR; PG8_MMA(1, 0, At, B0); PG8_MMA(1, 1, At, B1); PG8_BAR; PG8_SCHED;
            PG8_LDB(B0, 1, 0); PG8_LDB(B1, 1, 1); PG8_SCHED; PG8_LDA(At, 1, 0); PG8_STAGE(PG8_SA(0, 1), a2 + hA, voffA);
            PG8_WAIT_V(8); PG8_WAIT_L(0); PG8_BAR; PG8_MMA(0, 0, At, B0); PG8_MMA(0, 1, At, B1); PG8_BAR; PG8_SCHED;
            PG8_LDA(At, 1, 1); PG8_STAGE(PG8_SB(1, 0), b3, voffB); PG8_STAGE(PG8_SB(1, 1), b3 + hB, voffB); PG8_STAGE(PG8_SA(1, 0), a3, voffA);
            PG8_WAIT_V(8); PG8_WAIT_L(0); PG8_BAR; PG8_MMA(1, 0, At, B0); PG8_MMA(1, 1, At, B1); PG8_BAR; PG8_SCHED;
            } else {
            PG8_LDB(B0, 0, 0); PG8_SCHED; PG8_LDA(At, 0, 0); PG8_STAGE(PG8_SA(1, 1), a1 + hA, voffA);
            PG8_WAIT_L(8); PG8_BAR; PG8_WAIT_L(0); PG8_MMA(0, 0, At, B0); PG8_BAR; PG8_SCHED;
            PG8_LDB(B1, 0, 1); PG8_STAGE(PG8_SB(0, 0), b2, voffB);
            PG8_BAR; PG8_WAIT_L(0); PG8_MMA(0, 1, At, B1); PG8_BAR;
            PG8_LDA(At, 0, 1); PG8_STAGE(PG8_SA(0, 0), a2, voffA);
            PG8_BAR; PG8_WAIT_L(0); PG8_MMA(1, 0, At, B0); PG8_BAR; PG8_SCHED;
            PG8_STAGE(PG8_SB(0, 1), b2 + hB, voffB);
            PG8_WAIT_V(6); PG8_BAR; PG8_MMA(1, 1, At, B1); PG8_BAR;
            PG8_LDB(B0, 1, 0); PG8_SCHED; PG8_LDA(At, 1, 0); PG8_STAGE(PG8_SA(0, 1), a2 + hA, voffA);
            PG8_WAIT_L(8); PG8_BAR; PG8_WAIT_L(0); PG8_MMA(0, 0, At, B0); PG8_BAR; PG8_SCHED;
            PG8_LDB(B1, 1, 1); PG8_STAGE(PG8_SB(1, 0), b3, voffB);
            PG8_BAR; PG8_WAIT_L(0); PG8_MMA(0, 1, At, B1); PG8_BAR;
            PG8_LDA(At, 1, 1); PG8_STAGE(PG8_SA(1, 0), a3, voffA);
            PG8_BAR; PG8_WAIT_L(0); PG8_MMA(1, 0, At, B0); PG8_BAR; PG8_SCHED;
            PG8_STAGE(PG8_SB(1, 1), b3 + hB, voffB);
            PG8_WAIT_V(6); PG8_BAR; PG8_MMA(1, 1, At, B1); PG8_BAR;
            }
        }
        if constexpr (ALIGN_EPI) { if (wr == 0) PG8_BAR; }
        if constexpr (!Epi::AFTER_DRAIN) E(acc, cur, wr, wc, fr, fq);
        if (!has_next) break;
#pragma unroll
        for (int a = 0; a < 2; ++a)
#pragma unroll
            for (int b = 0; b < 2; ++b)
#pragma unroll
                for (int m = 0; m < 4; ++m)
#pragma unroll
                    for (int n = 0; n < 2; ++n) acc[a][b][m][n] = (f32x4){0.f, 0.f, 0.f, 0.f};
        cur = nxt; cA = nA; cA2 = nA2; cB = nB; ++ui;
        if constexpr (ALIGN_EPI) { if (wr == 1) PG8_BAR; }
    }
    PG8_WAIT_V(0);
    if constexpr (!ALIGN_EPI) { if (wr == 0) PG8_BAR; }
    PG8_BAR;
    if constexpr (Epi::AFTER_DRAIN) E.fused(acc, cur, wr, wc, fr, fq, lds, tid);
#undef PG8_ATILE
#undef PG8_SA
#undef PG8_SB
#undef PG8_STAGE
#undef PG8_LDA
#undef PG8_LDB
#undef PG8_MMA
#undef PG8_WAIT_V
#undef PG8_WAIT_L
#undef PG8_BAR
#undef PG8_SCHED
}
}

#define XB_TMO      128
#define XB_XCNT(j)  (256  + 64 * (j))
#define XB_XSUB(j)  (1280 + 64 * (j))
#define XB_XGEN(j)  (2304 + 64 * (j))
#define XB_TOP      3328
#define XB_TOPGEN   3392
#define XCD_BAR_WORDS 3456
#define XB_SPIN_CAP (1u << 18)

__device__ __forceinline__ unsigned xb_ld(unsigned* p)              { return __hip_atomic_load(p, __ATOMIC_RELAXED, __HIP_MEMORY_SCOPE_AGENT); }
__device__ __forceinline__ unsigned xb_add(unsigned* p, unsigned v) { return __hip_atomic_fetch_add(p, v, __ATOMIC_RELAXED, __HIP_MEMORY_SCOPE_AGENT); }
__device__ __forceinline__ unsigned xb_xcc_id() { return (unsigned)__builtin_amdgcn_s_getreg((3 << 11) | 20) & 0xFu; }
#define XB_SPIN(cond, bar) do { unsigned _sp = 0; while (cond) { __builtin_amdgcn_s_sleep(1); \
    if ((++_sp & 255u) == 0u) { if (xb_ld(&(bar)[XB_TMO])) break; if (_sp > XB_SPIN_CAP) { atomicAdd(&(bar)[XB_TMO], 1u); break; } } } } while (0)

struct XcdBarrier {
    unsigned* bar; unsigned x;
    volatile LAS unsigned* st;
};

__device__ __forceinline__ XcdBarrier xcd_barrier_post(unsigned* bar, volatile LAS unsigned* st) {
    XcdBarrier b; b.bar = bar; b.x = xb_xcc_id(); b.st = st;
    if (threadIdx.x == 0) (void)xb_add(&bar[XB_XCNT(b.x)], 1u);
    return b;
}
__device__ __forceinline__ void xcd_barrier_complete(unsigned* bar, unsigned x, unsigned& nloc, unsigned& nx) {
    const unsigned G = gridDim.x * gridDim.y * gridDim.z;
    unsigned sum, cnt, mine, sp = 0u;
    for (;;) {
        sum = 0u; cnt = 0u; mine = 0u;
#pragma unroll
        for (unsigned j = 0; j < 16; ++j) { const unsigned c = xb_ld(&bar[XB_XCNT(j)]); sum += c; cnt += (c > 0u) ? 1u : 0u; mine = (j == x) ? c : mine; }
        if (sum == G) break;
        __builtin_amdgcn_s_sleep(1);
        if ((++sp & 255u) == 0u) { if (xb_ld(&bar[XB_TMO])) break; if (sp > XB_SPIN_CAP) { atomicAdd(&bar[XB_TMO], 1u); break; } }
    }
    nloc = mine > 0u ? mine : 1u; nx = cnt > 0u ? cnt : 1u;
}

__device__ __forceinline__ void xcd_barrier(const XcdBarrier& b) {
    asm volatile("s_waitcnt vmcnt(0)" ::: "memory");
    __syncthreads();
    if (threadIdx.x == 0) {
        unsigned* bar = b.bar;
        __builtin_amdgcn_s_waitcnt(0);
        unsigned nloc = b.st[0], nx = b.st[1];
        if (nloc == 0u) { xcd_barrier_complete(bar, b.x, nloc, nx); b.st[0] = nloc; b.st[1] = nx; }
        const unsigned old = xb_add(&bar[XB_XSUB(b.x)], 1u);
        const unsigned gen = old / nloc;
        if (old + 1u == (gen + 1u) * nloc) {
            __builtin_amdgcn_fence(__ATOMIC_RELEASE, "agent");
            asm volatile("s_waitcnt vmcnt(0)" ::: "memory");
            const unsigned og = xb_add(&bar[XB_TOP], 1u);
            const unsigned tg = og / nx;
            if (og + 1u == (tg + 1u) * nx) xb_add(&bar[XB_TOPGEN], 1u);
            else XB_SPIN(xb_ld(&bar[XB_TOPGEN]) == tg, bar);
            __builtin_amdgcn_fence(__ATOMIC_ACQUIRE, "agent");
            xb_add(&bar[XB_XGEN(b.x)], 1u);
            asm volatile("s_waitcnt vmcnt(0)" ::: "memory");
        } else {
            XB_SPIN(xb_ld(&bar[XB_XGEN(b.x)]) == gen, bar);
            __builtin_amdgcn_fence(__ATOMIC_ACQUIRE, "agent");
            asm volatile("s_waitcnt vmcnt(0)" ::: "memory");
        }
    }
    __syncthreads();
}


__device__ __forceinline__ void xcd_barrier2(const XcdBarrier& b, const bool local) {
    asm volatile("s_waitcnt vmcnt(0)" ::: "memory");
    __syncthreads();
    if (threadIdx.x == 0) {
        unsigned* bar = b.bar;
        __builtin_amdgcn_s_waitcnt(0);
        unsigned nloc = b.st[0], nx = b.st[1]; const bool first = nloc == 0u;
        if (first) { xcd_barrier_complete(bar, b.x, nloc, nx); b.st[0] = nloc; b.st[1] = nx; }
        const unsigned old = xb_add(&bar[XB_XSUB(b.x)], 1u);
        const unsigned gen = old / nloc;
        if (old + 1u == (gen + 1u) * nloc) {
            if (!local) {
                __builtin_amdgcn_fence(__ATOMIC_RELEASE, "agent");
                asm volatile("s_waitcnt vmcnt(0)" ::: "memory");
                const unsigned og = xb_add(&bar[XB_TOP], 1u);
                const unsigned tg = og / nx;
                if (og + 1u == (tg + 1u) * nx) xb_add(&bar[XB_TOPGEN], 1u);
                else XB_SPIN(xb_ld(&bar[XB_TOPGEN]) == tg, bar);
            }
            __builtin_amdgcn_fence(__ATOMIC_ACQUIRE, "agent");
            xb_add(&bar[XB_XGEN(b.x)], 1u);
            asm volatile("s_waitcnt vmcnt(0)" ::: "memory");
        } else {
            XB_SPIN(xb_ld(&bar[XB_XGEN(b.x)]) == gen, bar);
            __builtin_amdgcn_fence(__ATOMIC_ACQUIRE, "agent");
            asm volatile("s_waitcnt vmcnt(0)" ::: "memory");
        }
        if (first) { const unsigned m = xb_ld(&bar[64]) & 0xffu; b.st[2] = (m != 0u && (m & (m - 1u)) == 0u && gridDim.x == 256u) ? 1u : 2u; }
    }
    __syncthreads();
}

struct Args {
    const float* in[26];
    float* out; unsigned char* ws;
    int ph_lo, ph_hi;
};
enum { I_X = 0, I_NMIX, I_NMLP, I_NFIN, I_S5WIN, I_S5LRE, I_S5LIM, I_S5STEP, I_S5BRE, I_S5BIM, I_S5CRE, I_S5CIM, I_S5D, I_S5WG, I_S5WO,
       I_DAQKV, I_DALQ1, I_DALK1, I_DALQ2, I_DALK2, I_DASUB, I_DAWO, I_POOLW, I_POOLS, I_W1, I_W2 };

constexpr int LDS_BYTES = 147456;
constexpr float LAM_INIT = 0.35550906f;
constexpr float QSCALE = 0.125f * 1.4426950408889634f;

struct Ctx { LAS unsigned char* lds; const Args* a; int tid, lane, wave, G, bid; };

__device__ __forceinline__ void transpose_item(const float* W, int K, int ldw, int k0, int n0, bf16_t* WT, int dstmode, int dst0, const float* ks, int ksmask, float kmul, const float* ns, bool usens, LAS float* scr, int lane) {
    const int l15 = lane & 15, l4 = lane >> 4;
    const f32x4 nq = *(const f32x4*)(ns + (n0 & 255) + l15 * 4); const float ns0 = usens ? nq[0] : 1.f, ns1 = usens ? nq[1] : 1.f, ns2 = usens ? nq[2] : 1.f, ns3 = usens ? nq[3] : 1.f;
#pragma unroll
    for (int i = 0; i < 16; ++i) { const int k = 4 * i + l4; f32x4 v = gldf4nt(W + (size_t)(k0 + k) * ldw + n0 + l15 * 4);
        const float sc = ks ? kmul * ks[(k0 + k) & ksmask] : kmul;
        LAS float* d = scr + k * 65 + l15 * 4; d[0] = v[0] * sc * ns0; d[1] = v[1] * sc * ns1; d[2] = v[2] * sc * ns2; d[3] = v[3] * sc * ns3; }
    asm volatile("s_waitcnt lgkmcnt(0)" ::: "memory");
    const int c = lane & 7;
#pragma unroll
    for (int j = 0; j < 8; ++j) { const int nn = (lane >> 3) + 8 * j; const LAS float* sp = scr + (8 * c) * 65 + nn;
        u32x4 o; o.x = cvt_pk_bf16(sp[0 * 65], sp[1 * 65]); o.y = cvt_pk_bf16(sp[2 * 65], sp[3 * 65]); o.z = cvt_pk_bf16(sp[4 * 65], sp[5 * 65]); o.w = cvt_pk_bf16(sp[6 * 65], sp[7 * 65]);
        int drow = dst0 + nn; if (dstmode) { const int n = n0 + nn, w = n & 255; drow = (n & ~255) + ((w & 63) >> 5) * 128 + (w >> 6) * 32 + (w & 31); }
        gst16(WT + (size_t)drow * K + k0 + 8 * c, o); }
    asm volatile("s_waitcnt lgkmcnt(0)" ::: "memory");
}

__device__ __forceinline__ void s5_item(const Ctx& F, int j, int g, int part);
__device__ __forceinline__ void prologue(const Ctx& F) {
    const Args& A = *F.a; unsigned char* ws = A.ws;
    LAS float* scr = (LAS float*)(F.lds + F.wave * 16640);
    const int gw = F.bid * 8 + F.wave, NGW = F.G * 8;
    constexpr int I_DD = (D / 64) * (D / 64);
    constexpr int I_QKV = (D / 64) * (3 * D / 64);
    constexpr int I_POOL = 4 * 4 * 4;
    constexpr int I_MLP = (D / 64) * (FF / 64);
    constexpr int NITEMS = 6 * I_DD + I_QKV + I_DD + I_POOL + 8 * I_MLP;
    for (int it = gw; it < NITEMS; it += NGW) {
        int r = it;
        const float* W; int K, ldw, kb, nb, dstmode = 0, dsub = 0, ksmask = D - 1; bf16_t* WT; const float* ks = nullptr; float kmul = 1.f; const float* ns = A.in[I_POOLS]; bool usens = false;
        if (r < 6 * I_DD) { const int which = r / I_DD, j = which & 1, kind = which >> 1; r %= I_DD; kb = r / (D / 64); nb = r % (D / 64); K = D; ldw = D;
            W = (kind == 0 ? A.in[I_S5WIN] : kind == 1 ? A.in[I_S5WG] : A.in[I_S5WO]) + (size_t)j * D * D;
            WT = (bf16_t*)(ws + (kind == 0 ? WS_WIN : kind == 1 ? WS_WGATE : WS_WOUT) + (size_t)j * 2 * MiB);
            if (kind == 0) ks = A.in[I_NMIX] + (j ? 3 : 0) * D; }
        else if ((r -= 6 * I_DD) < I_QKV) { kb = r / (3 * D / 64); nb = r % (3 * D / 64); K = D; ldw = 3 * D; W = A.in[I_DAQKV]; ks = A.in[I_NMIX] + 1 * D;
            if (nb < 32) { WT = (bf16_t*)(ws + WS_WQK); dstmode = 1; } else { WT = (bf16_t*)(ws + WS_WV); dsub = 2048; } }
        else if ((r -= I_QKV) < I_DD) { kb = r / (D / 64); nb = r % (D / 64); K = D; ldw = D; W = A.in[I_DAWO]; WT = (bf16_t*)(ws + WS_WO); ks = A.in[I_DASUB]; ksmask = 127; kmul = 1.f - LAM_INIT; }
        else if ((r -= I_DD) < I_POOL) { const int g = r / 16, q = r % 16; kb = q / 4; nb = q % 4; K = 256; ldw = 256; W = A.in[I_POOLW] + (size_t)g * 65536; WT = (bf16_t*)(ws + WS_WPOOL) + (size_t)g * 65536;
            ks = A.in[I_NMIX] + 2 * D + g * 256; ksmask = 255; ns = A.in[I_POOLS] + g * 256; usens = true; }
        else { r -= I_POOL; const int which = r / I_MLP; r %= I_MLP; const int i = which >> 1;
            if ((which & 1) == 0) { kb = r / (FF / 64); nb = r % (FF / 64); K = D; ldw = FF; W = A.in[I_W1] + (size_t)i * D * FF; WT = (bf16_t*)(ws + WS_W1 + (size_t)i * 8 * MiB); ks = A.in[I_NMLP] + i * D; }
            else { kb = r / (D / 64); nb = r % (D / 64); K = FF; ldw = D; W = A.in[I_W2] + (size_t)i * D * FF; WT = (bf16_t*)(ws + WS_W2 + (size_t)i * 8 * MiB); } }
        transpose_item(W, K, ldw, kb * 64, nb * 64, WT, dstmode, nb * 64 - dsub, ks, ksmask, kmul, ns, usens, scr, F.lane);
    }
    float* stats = (float*)(ws + WS_STATS); bf16_t* xb = (bf16_t*)(ws + WS_XB);
    for (int m = gw; m < T; m += NGW) {
        const g_f32x4* xr = (const g_f32x4*)(A.in[I_X] + (size_t)m * D) + F.lane; float s = 0.f; g_u32x2* o8 = (g_u32x2*)(xb + (size_t)m * D) + F.lane;
        f32x4 xv[4];
#pragma unroll
        for (int j = 0; j < 4; ++j) xv[j] = __builtin_nontemporal_load(xr + 64 * j);
#pragma unroll
        for (int j = 0; j < 4; ++j) { const f32x4 v = xv[j]; s += (v[0] * v[0] + v[1] * v[1]) + (v[2] * v[2] + v[3] * v[3]); u32x2 w; w.x = cvt_pk_bf16(v[0], v[1]); w.y = cvt_pk_bf16(v[2], v[3]); o8[64 * j] = w; }
#pragma unroll
        for (int o = 1; o < 64; o <<= 1) s += __shfl_xor(s, o);
        if (F.lane < 16) stats[(size_t)m * 16 + F.lane] = F.lane == 0 ? s : 0.f;
    }
    { float* rc = (float*)(ws + WS_ROPE); float* rsn = rc + SEQ * 32;
      for (int i = F.bid * 512 + F.tid; i < SEQ * 32; i += F.G * 512) { const int pos = i >> 5, f = i & 31; const float invf = powf(10000.0f, -(float)(2 * f) / 64.0f); const float ang = (float)pos * invf; float sn, cs; sincosf(ang, &sn, &cs); rc[i] = cs; rsn[i] = sn; } }
    if (F.bid == 0 && F.wave == 0) { float a = A.in[I_DALQ1][F.lane] * A.in[I_DALK1][F.lane], b = A.in[I_DALQ2][F.lane] * A.in[I_DALK2][F.lane];
#pragma unroll
        for (int o = 1; o < 64; o <<= 1) { a += __shfl_xor(a, o); b += __shfl_xor(b, o); }
        if (F.lane == 0) ((float*)(ws + WS_MISC))[0] = expf(a) - expf(b) + LAM_INIT; }
#if SSM_GEMM
    for (int it = F.bid; it < 256; it += F.G) s5_item(F, it >> 7, (it >> 1) & 63, it & 1);
#endif
}

__device__ __forceinline__ void ssm_naive(const Ctx& F, int j, const bf16_t* U, bf16_t* Z) {
    const Args& A = *F.a; const int gw = F.bid * 8 + F.wave, NGW = F.G * 8, p = F.lane;
    for (int w = gw; w < NB * 64; w += NGW) {
        const int b = w >> 6, g = w & 63;
        const float lr = fminf(A.in[I_S5LRE][(j * 64 + g) * 64 + p], -1e-4f), li = A.in[I_S5LIM][(j * 64 + g) * 64 + p], dt = expf(A.in[I_S5STEP][j * 64 + g]);
        const float mag = expf(lr * dt); float sn, cs; sincosf(li * dt, &sn, &cs); const float are = mag * cs, aim = mag * sn;
        const float den = lr * lr + li * li, nr = are - 1.0f; const float fre = (nr * lr + aim * li) / den, fim = (aim * lr - nr * li) / den;
        float Bre[16], Bim[16], Cre[16], Cim[16];
#pragma unroll
        for (int h = 0; h < 16; ++h) { const float br = A.in[I_S5BRE][((size_t)(j * 64 + g) * 64 + p) * 16 + h], bi = A.in[I_S5BIM][((size_t)(j * 64 + g) * 64 + p) * 16 + h];
            Bre[h] = fre * br - fim * bi; Bim[h] = fre * bi + fim * br;
            Cre[h] = A.in[I_S5CRE][((size_t)(j * 64 + g) * 16 + h) * 64 + p]; Cim[h] = A.in[I_S5CIM][((size_t)(j * 64 + g) * 16 + h) * 64 + p]; }
        const float dsk = A.in[I_S5D][j * D + g * 16 + (p & 15)];
        float xr = 0.f, xi = 0.f;
        for (int t = 0; t < SEQ; ++t) {
            const size_t off = (size_t)(b * SEQ + t) * D + g * 16;
            const u32x4 u0 = *(const u32x4*)(U + off), u1 = *(const u32x4*)(U + off + 8);
            float uu[16] = {bflo(u0.x), bfhi(u0.x), bflo(u0.y), bfhi(u0.y), bflo(u0.z), bfhi(u0.z), bflo(u0.w), bfhi(u0.w), bflo(u1.x), bfhi(u1.x), bflo(u1.y), bfhi(u1.y), bflo(u1.z), bfhi(u1.z), bflo(u1.w), bfhi(u1.w)};
            float bur = 0.f, bui = 0.f;
#pragma unroll
            for (int h = 0; h < 16; ++h) { bur += Bre[h] * uu[h]; bui += Bim[h] * uu[h]; }
            const float nxr = are * xr - aim * xi + bur, nxi = are * xi + aim * xr + bui; xr = nxr; xi = nxi;
            float ysel = 0.f, usel = 0.f;
#pragma unroll
            for (int h = 0; h < 16; ++h) { float v = Cre[h] * xr - Cim[h] * xi;
#pragma unroll
                for (int o = 1; o < 64; o <<= 1) v += __shfl_xor(v, o);
                if ((p & 15) == h) { ysel = v; usel = uu[h]; } }
            if (p < 16) Z[off + p] = f2bf(gelu_tanh(ysel + dsk * usel));
        }
    }
}


__device__ __forceinline__ void s5_item(const Ctx& F, int j, int g, int part) {
    const Args& A = *F.a; unsigned char* ws = A.ws; const int tid = F.tid;
    LAS float* apr = (LAS float*)F.lds; LAS float* api = apr + 2112; LAS float* bbr = api + 2112; LAS float* bbi = bbr + 1024; LAS float* cre = bbi + 1024; LAS float* cim = cre + 1024; LAS float* Km = cim + 1024;
    __syncthreads();
    const float dt = expf(A.in[I_S5STEP][j * 64 + g]);
    for (int e = tid; e < 33 * 64; e += 512) { const int tau = e >> 6, p = e & 63;
        const float lr = fminf(A.in[I_S5LRE][(j * 64 + g) * 64 + p], -1e-4f), li = A.in[I_S5LIM][(j * 64 + g) * 64 + p];
        const float mg = __expf((float)tau * lr * dt); double rev = (double)tau * (double)li * (double)dt * 0.15915494309189535; rev -= rint(rev);
        apr[e] = mg * __builtin_amdgcn_cosf((float)rev); api[e] = mg * __builtin_amdgcn_sinf((float)rev); }
    for (int e = tid; e < 1024; e += 512) { const int p = e >> 4, h = e & 15;
        const float lr = fminf(A.in[I_S5LRE][(j * 64 + g) * 64 + p], -1e-4f), li = A.in[I_S5LIM][(j * 64 + g) * 64 + p];
        double rev = (double)li * (double)dt * 0.15915494309189535; rev -= rint(rev); const float cs = __builtin_amdgcn_cosf((float)rev), sn = __builtin_amdgcn_sinf((float)rev), sh = __builtin_amdgcn_sinf((float)(0.5 * rev));
        const float mm1 = expm1f(lr * dt), mg = mm1 + 1.f, aim = mg * sn, nr = mm1 * cs - 2.f * sh * sh;
        const float den = lr * lr + li * li, fre = (nr * lr + aim * li) / den, fim = (aim * lr - nr * li) / den;
        const float br = A.in[I_S5BRE][((size_t)(j * 64 + g) * 64 + p) * 16 + h], bi = A.in[I_S5BIM][((size_t)(j * 64 + g) * 64 + p) * 16 + h];
        bbr[e] = fre * br - fim * bi; bbi[e] = fre * bi + fim * br;
        cre[e] = A.in[I_S5CRE][(size_t)(j * 64 + g) * 1024 + e]; cim[e] = A.in[I_S5CIM][(size_t)(j * 64 + g) * 1024 + e]; }
    __syncthreads();
    if (part == 0 && tid < 64) { f32x4 v = {apr[16 * 64 + tid], api[16 * 64 + tid], apr[32 * 64 + tid], api[32 * 64 + tid]}; ((f32x4*)(ws + WS_APW))[(j * 64 + g) * 64 + tid] = v; }
    if (part == 1) for (int e = tid; e < 4096; e += 512) { const int tau = e >> 8, h = (e >> 4) & 15, hp = e & 15; float sacc = 0.f;
        for (int p = 0; p < 64; ++p) { const float cr = cre[h * 64 + p], ci = cim[h * 64 + p], ar = apr[tau * 64 + p], ai = api[tau * 64 + p]; const float wr = cr * ar - ci * ai, wi = cr * ai + ci * ar;
            sacc += wr * bbr[p * 16 + hp] - wi * bbi[p * 16 + hp]; }
        Km[e] = sacc; }
    __syncthreads();
    bf16_t* Wst = (bf16_t*)(ws + WS_WST + (size_t)j * 16 * MiB) + (size_t)g * 256 * 512;
    if (part == 0) for (int v = tid; v < 256 * 64; v += 512) { const int n = v >> 6, kv = v & 63, jtok = kv >> 1, h0 = (kv & 1) * 8, q = n >> 7, ri = (n >> 6) & 1, p = n & 63; const int e = (q ? 31 : 15) - jtok;
        float o[8];
        if (e >= 0) { const float ar = apr[e * 64 + p], ai = api[e * 64 + p];
#pragma unroll
            for (int k = 0; k < 8; ++k) { const float br = bbr[p * 16 + h0 + k], bi = bbi[p * 16 + h0 + k]; o[k] = ri ? (ar * bi + ai * br) : (ar * br - ai * bi); } }
        else {
#pragma unroll
            for (int k = 0; k < 8; ++k) o[k] = 0.f; }
        u32x4 w; w.x = cvt_pk_bf16(o[0], o[1]); w.y = cvt_pk_bf16(o[2], o[3]); w.z = cvt_pk_bf16(o[4], o[5]); w.w = cvt_pk_bf16(o[6], o[7]);
        *(u32x4*)(Wst + (size_t)n * 512 + kv * 8) = w; }
    bf16_t* Wso = (bf16_t*)(ws + WS_WSO + (size_t)j * 12 * MiB) + (size_t)g * 256 * 384;
    if (part == 1) for (int v = tid; v < 256 * 48; v += 512) { const int n = v / 48, kv = v % 48, i = n >> 4, h = n & 15;
        float o[8];
        if (kv < 32) { const int jtok = kv >> 1, h0 = (kv & 1) * 8;
#pragma unroll
            for (int k = 0; k < 8; ++k) o[k] = jtok <= i ? Km[(i - jtok) * 256 + h * 16 + h0 + k] : 0.f; }
        else { const int kk = (kv - 32) * 8, ri = kk >> 6, p0 = kk & 63;
#pragma unroll
            for (int k = 0; k < 8; ++k) { const int p = p0 + k; const float ar = apr[(i + 1) * 64 + p], ai = api[(i + 1) * 64 + p], cr = cre[h * 64 + p], ci = cim[h * 64 + p]; o[k] = ri ? -(cr * ai + ci * ar) : (cr * ar - ci * ai); } }
        u32x4 w; w.x = cvt_pk_bf16(o[0], o[1]); w.y = cvt_pk_bf16(o[2], o[3]); w.z = cvt_pk_bf16(o[4], o[5]); w.w = cvt_pk_bf16(o[6], o[7]);
        *(u32x4*)(Wso + (size_t)n * 384 + kv * 8) = w; }
    __syncthreads();
}
__device__ __forceinline__ void ssm_scan(const Ctx& F, int j, const float* Sl, bf16_t* HB) {
    const f32x4* APW = (const f32x4*)(F.a->ws + WS_APW) + j * 4096;
    for (int gt = F.bid * 512 + F.tid; gt < 65536; gt += F.G * 512) {
        const int p = gt & 63, b = (gt >> 6) & 15, g = gt >> 10;
        const f32x4 aw = APW[g * 64 + p];
        const float* sp = Sl + ((size_t)g * 1024 + b * 64) * 256 + p;
        bf16_t* hp = HB + ((size_t)g * 2048 + b * 128) * 256 + p;
        float hr = 0.f, hi = 0.f;
#pragma unroll 4
        for (int m = 0; m < 64; ++m) {
            const float s16r = sp[m * 256], s16i = sp[m * 256 + 64], s32r = sp[m * 256 + 128], s32i = sp[m * 256 + 192];
            hp[(2 * m) * 256] = f2bf(hr); hp[(2 * m) * 256 + 64] = f2bf(hi);
            const float h1r = aw[0] * hr - aw[1] * hi + s16r, h1i = aw[0] * hi + aw[1] * hr + s16i;
            hp[(2 * m + 1) * 256] = f2bf(h1r); hp[(2 * m + 1) * 256 + 64] = f2bf(h1i);
            const float nr = aw[2] * hr - aw[3] * hi + s32r, ni = aw[2] * hi + aw[3] * hr + s32i; hr = nr; hi = ni;
        }
    }
}

namespace att {
constexpr int KBUF = 16384, VBUF = 16384, BUF = KBUF + VBUF, NBUF = 3, XOFF = 0, XROW = 528, XPAIR = 32 * XROW, OROW = 272;
__device__ __forceinline__ int kap(int m) { return (m & ~12) | ((m & 4) << 1) | ((m & 8) >> 1); }
__device__ __forceinline__ void unit(const Ctx& F, int b, int h, int qb, const bf16_t* Q, const bf16_t* Kg, const bf16_t* VT, bf16_t* O, float lam) {
    LAS unsigned char* lds = F.lds; const int lane = F.lane, wid = F.wave, r32 = lane & 31, hi = lane >> 5, rg = wid >> 1, s = wid & 1;
    const size_t tok0 = (size_t)b * SEQ; const int q0 = qb * 128 + rg * 32;
    bf16x8 qf[4];
    { const bf16_t* qp = Q + (tok0 + q0 + r32) * D + h * 128 + s * 64 + hi * 8;
#pragma unroll
      for (int d0 = 0; d0 < 4; ++d0) qf[d0] = *(const GAS bf16x8*)(qp + d0 * 16); }
    f32x16 o[4];
#pragma unroll
    for (int db = 0; db < 4; ++db)
#pragma unroll
        for (int r = 0; r < 16; ++r) o[db][r] = 0.f;
    float mrun = -1e30f, lrun = 0.f;
    const int NT = qb * 2 + 2, cq = qb * 2 + (rg >> 1);
    const bf16_t* ksrc[2]; const bf16_t* vsrc[2];
#pragma unroll
    for (int i = 0; i < 2; ++i) { const int kr = 4 * (2 * wid + i) + (lane >> 4), ks = (lane & 15) ^ (kr & 15); ksrc[i] = Kg + (tok0 + kr) * D + h * 128 + ks * 8;
        const int vr = 8 * (2 * wid + i) + (lane >> 3), vs = (lane & 7) ^ ((vr >> 1) & 7); vsrc[i] = VT + (size_t)(h * 128 + vr) * T + tok0 + vs * 8; }
#define ATT_DMA(j, bofs) do { _Pragma("unroll") for (int _i = 0; _i < 2; ++_i) { \
        __builtin_amdgcn_global_load_lds((const unsigned*)(ksrc[_i] + (size_t)(j) * 64 * D), (LAS unsigned*)(lds + (bofs) + (2 * wid + _i) * 1024), 16, 0, 0); \
        __builtin_amdgcn_global_load_lds((const unsigned*)(vsrc[_i] + (size_t)(j) * 64), (LAS unsigned*)(lds + (bofs) + KBUF + (2 * wid + _i) * 1024), 16, 0, 0); } } while (0)
    const int krow = kap(r32);
    int kad[4], vad[4];
#pragma unroll
    for (int i = 0; i < 4; ++i) { kad[i] = krow * 256 + (((s * 8 + i * 2 + hi) ^ (krow & 15)) << 4); vad[i] = r32 * 128 + (((i * 2 + hi) ^ ((r32 >> 1) & 7)) << 4); }
    bf16x8 pf[4];
#define ATT_S(bofs) do { f32x16 sc[2]; bf16x8 kfr[8]; \
        _Pragma("unroll") for (int d0 = 0; d0 < 4; ++d0) _Pragma("unroll") for (int hf = 0; hf < 2; ++hf) kfr[d0 * 2 + hf] = *(const LAS bf16x8*)(lds + (kad[d0] + (bofs)) + hf * 8192); \
        _Pragma("unroll") for (int r = 0; r < 16; ++r) { sc[0][r] = 0.f; sc[1][r] = 0.f; } \
        asm volatile("s_waitcnt lgkmcnt(0)" ::: "memory"); __builtin_amdgcn_sched_barrier(0); \
        _Pragma("unroll") for (int d0 = 0; d0 < 4; ++d0) _Pragma("unroll") for (int hf = 0; hf < 2; ++hf) sc[hf] = __builtin_amdgcn_mfma_f32_32x32x16_bf16(kfr[d0 * 2 + hf], qf[d0], sc[hf], 0, 0, 0); \
        __builtin_amdgcn_sched_barrier(0); \
        float mx = fmaxf(sc[0][0], sc[1][0]); \
        _Pragma("unroll") for (int r = 1; r < 16; ++r) mx = fmaxf(mx, fmaxf(sc[0][r], sc[1][r])); \
        { auto rr = __builtin_amdgcn_permlane32_swap(__float_as_uint(mx), __float_as_uint(mx), false, false); mx = fmaxf(__uint_as_float(rr[0]), __uint_as_float(rr[1])); } \
        if (__any(mx > mrun)) { const float mn = fmaxf(mrun, mx), alpha = __builtin_amdgcn_exp2f(mrun - mn); mrun = mn; lrun *= alpha; \
            _Pragma("unroll") for (int db = 0; db < 4; ++db) _Pragma("unroll") for (int r = 0; r < 16; ++r) o[db][r] *= alpha; } \
        float ls = 0.f; \
        _Pragma("unroll") for (int hf = 0; hf < 2; ++hf) _Pragma("unroll") for (int r = 0; r < 16; ++r) { const float pv = __builtin_amdgcn_exp2f(sc[hf][r] - mrun); sc[hf][r] = pv; ls += pv; } \
        lrun += ls; \
        _Pragma("unroll") for (int kk = 0; kk < 4; ++kk) { const int hf = kk >> 1, r0 = (kk & 1) * 8; u32x4 w; \
            w.x = cvt_pk_bf16(sc[hf][r0 + 0], sc[hf][r0 + 1]); w.y = cvt_pk_bf16(sc[hf][r0 + 2], sc[hf][r0 + 3]); w.z = cvt_pk_bf16(sc[hf][r0 + 4], sc[hf][r0 + 5]); w.w = cvt_pk_bf16(sc[hf][r0 + 6], sc[hf][r0 + 7]); \
            pf[kk] = __builtin_bit_cast(bf16x8, w); } } while (0)
#define ATT_PV(bofs) do { bf16x8 vfa[8], vfb[8]; \
        _Pragma("unroll") for (int kk = 0; kk < 2; ++kk) _Pragma("unroll") for (int db = 0; db < 4; ++db) vfa[kk * 4 + db] = *(const LAS bf16x8*)(lds + (vad[kk] + (bofs)) + KBUF + db * 4096); \
        asm volatile("s_waitcnt lgkmcnt(0)" ::: "memory"); __builtin_amdgcn_sched_barrier(0); \
        _Pragma("unroll") for (int kk = 0; kk < 2; ++kk) _Pragma("unroll") for (int db = 0; db < 4; ++db) vfb[kk * 4 + db] = *(const LAS bf16x8*)(lds + (vad[kk + 2] + (bofs)) + KBUF + db * 4096); \
        __builtin_amdgcn_sched_barrier(0); \
        _Pragma("unroll") for (int kk = 0; kk < 2; ++kk) _Pragma("unroll") for (int db = 0; db < 4; ++db) o[db] = __builtin_amdgcn_mfma_f32_32x32x16_bf16(vfa[kk * 4 + db], pf[kk], o[db], 0, 0, 0); \
        asm volatile("s_waitcnt lgkmcnt(0)" ::: "memory"); __builtin_amdgcn_sched_barrier(0); \
        _Pragma("unroll") for (int kk = 0; kk < 2; ++kk) _Pragma("unroll") for (int db = 0; db < 4; ++db) o[db] = __builtin_amdgcn_mfma_f32_32x32x16_bf16(vfb[kk * 4 + db], pf[kk + 2], o[db], 0, 0, 0); \
        __builtin_amdgcn_sched_barrier(0); } while (0)
    ATT_DMA(0, 0); ATT_DMA(1, BUF);
#pragma nounroll
    for (int j = 0; j < NT; ++j) {
        if (j + 1 < NT) asm volatile("s_waitcnt vmcnt(4) lgkmcnt(0)" ::: "memory"); else asm volatile("s_waitcnt vmcnt(0) lgkmcnt(0)" ::: "memory");
        __builtin_amdgcn_s_barrier(); asm volatile("" ::: "memory");
        if (j + 2 < NT) ATT_DMA(j + 2, ((j + 2) % 3) * BUF);
        if (j <= cq) { const int bo = (j % 3) * BUF; ATT_S(bo); ATT_PV(bo); }
    }
#undef ATT_DMA
#undef ATT_S
#undef ATT_PV
    float l; { auto rr = __builtin_amdgcn_permlane32_swap(__float_as_uint(lrun), __float_as_uint(lrun), false, false); l = __uint_as_float(rr[0]) + __uint_as_float(rr[1]); }
    LAS unsigned char* xp = lds + XOFF + rg * XPAIR;
    __syncthreads();
    if (s == 1) { const float sc2 = lam / l;
#pragma unroll
        for (int db = 0; db < 4; ++db)
#pragma unroll
            for (int rq = 0; rq < 4; ++rq) { f32x4 v = {o[db][4 * rq] * sc2, o[db][4 * rq + 1] * sc2, o[db][4 * rq + 2] * sc2, o[db][4 * rq + 3] * sc2};
                *(LAS f32x4*)(xp + r32 * XROW + (32 * db + 8 * rq + 4 * hi) * 4) = v; } }
    __syncthreads();
    if (s == 0) { const float i1 = 1.f / l; float ssq = 0.f;
#pragma unroll
        for (int db = 0; db < 4; ++db)
#pragma unroll
            for (int rq = 0; rq < 4; ++rq) { const f32x4 x = *(const LAS f32x4*)(xp + r32 * XROW + (32 * db + 8 * rq + 4 * hi) * 4);
#pragma unroll
                for (int k = 0; k < 4; ++k) { const float v = o[db][4 * rq + k] * i1 - x[k]; o[db][4 * rq + k] = v; ssq += v * v; } }
        { auto rr = __builtin_amdgcn_permlane32_swap(__float_as_uint(ssq), __float_as_uint(ssq), false, false); ssq = __uint_as_float(rr[0]) + __uint_as_float(rr[1]); }
        const float rn = rsqrtf(ssq * (1.0f / 128.0f) + EPS);
        asm volatile("s_waitcnt lgkmcnt(0)" ::: "memory");
#pragma unroll
        for (int db = 0; db < 4; ++db)
#pragma unroll
            for (int rq = 0; rq < 4; ++rq) { u32x2 w; w.x = cvt_pk_bf16(o[db][4 * rq] * rn, o[db][4 * rq + 1] * rn); w.y = cvt_pk_bf16(o[db][4 * rq + 2] * rn, o[db][4 * rq + 3] * rn);
                *(LAS u32x2*)(xp + r32 * OROW + (32 * db + 8 * rq + 4 * hi) * 2) = w; }
        asm volatile("s_waitcnt lgkmcnt(0)" ::: "memory");
        bf16_t* Ow = O + (tok0 + q0) * D + h * 128;
#pragma unroll
        for (int i = 0; i < 8; ++i) { const int idx = i * 64 + lane, row = idx >> 4, pc = idx & 15; const u32x4 v = *(const LAS u32x4*)(xp + row * OROW + pc * 16); gst16(Ow + (size_t)row * D + pc * 8, v); } }
    __syncthreads();
}
__device__ __forceinline__ void phase(const Ctx& F, const bf16_t* Q, const bf16_t* Kg, const bf16_t* VT, bf16_t* O, float lam) {
    for (int v = F.bid; v < 256; v += F.G) {
        const int xcd = v & 7, ci = v >> 3;
#pragma nounroll
        for (int i = 0; i < 8; ++i) { const int bh = xcd * 16 + (i >> 1) * 4 + (ci >> 3), p = ci & 7; const int qb = (i & 1) ? 15 - p : p; unit(F, bh >> 3, bh & 7, qb, Q, Kg, VT, O, lam); }
    }
}
}

__device__ __forceinline__ void pool_prep(const Ctx& F, const bf16_t* xb, const float* ss, bf16_t* P) {
    LAS float* rl = (LAS float*)F.lds;
    for (int blk = F.bid; blk < T / 128; blk += F.G) {
        const int tb = blk * 128;
        __syncthreads();
        if (F.tid < 144) { const int t = tb - 16 + F.tid; rl[F.tid] = t >= 0 ? rstd_of(ss, t) : 0.f; }
        __syncthreads();
        const int cg8 = F.tid & 127, sg = F.tid >> 7, c0 = cg8 * 8, g = c0 >> 8, w = 2 << g; const int t0 = tb + sg * 32, pos0 = t0 & (SEQ - 1);
        float sum[8];
#pragma unroll
        for (int k = 0; k < 8; ++k) sum[k] = 0.f;
        const int hstart = pos0 == 0 ? 0 : -(w - 1);
        for (int dt = hstart; dt < 0; ++dt) { const float r = rl[sg * 32 + 16 + dt]; const u32x4 v = gld16(xb + (size_t)(t0 + dt) * D + c0);
            sum[0] += bflo(v.x) * r; sum[1] += bfhi(v.x) * r; sum[2] += bflo(v.y) * r; sum[3] += bfhi(v.y) * r; sum[4] += bflo(v.z) * r; sum[5] += bfhi(v.z) * r; sum[6] += bflo(v.w) * r; sum[7] += bfhi(v.w) * r; }
#pragma nounroll
        for (int d4 = 0; d4 < 32; d4 += 4) {
            u32x4 vc[4], vo[4];
#pragma unroll
            for (int q = 0; q < 4; ++q) { const int dt = d4 + q; vc[q] = gld16(xb + (size_t)(t0 + dt) * D + c0); const int to = dt - w; vo[q] = gld16(xb + (size_t)(t0 + (to >= hstart ? to : dt)) * D + c0); }
#pragma unroll
            for (int q = 0; q < 4; ++q) { const int dt = d4 + q, pos = pos0 + dt; const float r = rl[sg * 32 + 16 + dt];
                float xv[8] = {bflo(vc[q].x) * r, bfhi(vc[q].x) * r, bflo(vc[q].y) * r, bfhi(vc[q].y) * r, bflo(vc[q].z) * r, bfhi(vc[q].z) * r, bflo(vc[q].w) * r, bfhi(vc[q].w) * r};
#pragma unroll
                for (int k = 0; k < 8; ++k) sum[k] += xv[k];
                if (dt - w >= hstart) { const float ro = rl[sg * 32 + 16 + dt - w];
                    sum[0] -= bflo(vo[q].x) * ro; sum[1] -= bfhi(vo[q].x) * ro; sum[2] -= bflo(vo[q].y) * ro; sum[3] -= bfhi(vo[q].y) * ro; sum[4] -= bflo(vo[q].z) * ro; sum[5] -= bfhi(vo[q].z) * ro; sum[6] -= bflo(vo[q].w) * ro; sum[7] -= bfhi(vo[q].w) * ro; }
                const float inv = 1.f / (float)(pos + 1 < w ? pos + 1 : w); u32x4 ow;
                ow.x = cvt_pk_bf16(sum[0] * inv - xv[0], sum[1] * inv - xv[1]); ow.y = cvt_pk_bf16(sum[2] * inv - xv[2], sum[3] * inv - xv[3]);
                ow.z = cvt_pk_bf16(sum[4] * inv - xv[4], sum[5] * inv - xv[5]); ow.w = cvt_pk_bf16(sum[6] * inv - xv[6], sum[7] * inv - xv[7]);
                gst16(P + ((size_t)g * T + t0 + dt) * 256 + (c0 & 255), ow); }
        }
    }
    __syncthreads();
}

__device__ __forceinline__ void final_norm(const Ctx& F, float* out, const bf16_t* xb, const float* ss, const float* gfin) {
    const bool loc = F.G == 256; const int gw = loc ? (F.bid & 7) * 4096 + (F.bid >> 3) * 128 + F.wave * 16 : F.bid * 8 + F.wave, NGW = loc ? 1 : F.G * 8, mend = loc ? gw + 16 : T;
    for (int m = gw; m < mend; m += NGW) { const float rs = rstd_of(ss, m); g_f32x4* orow = (g_f32x4*)(out + (size_t)m * D) + F.lane; const g_u32x2* xr = (const g_u32x2*)(xb + (size_t)m * D) + F.lane; const g_f32x4* gr = (const g_f32x4*)gfin + F.lane;
        u32x2 w[4]; f32x4 g[4];
#pragma unroll
        for (int j = 0; j < 4; ++j) { w[j] = xr[64 * j]; g[j] = gr[64 * j]; }
#pragma unroll
        for (int j = 0; j < 4; ++j) { f32x4 v = {bflo(w[j].x) * rs * g[j][0], bfhi(w[j].x) * rs * g[j][1], bflo(w[j].y) * rs * g[j][2], bfhi(w[j].y) * rs * g[j][3]}; orow[64 * j] = v; } }
}

enum { PH_PRO = 0,
       PH_L0_U, PH_L0_SST, PH_L0_SOUT, PH_L0_GATE, PH_L0_OUT, PH_L0_UP, PH_L0_DOWN,
       PH_L1_QKV, PH_L1_VT, PH_L1_ATT, PH_L1_WO, PH_L1_UP, PH_L1_DOWN,
       PH_L2_PREP, PH_L2_POOL, PH_L2_UP, PH_L2_DOWN,
       PH_L3_U, PH_L3_SST, PH_L3_SOUT, PH_L3_GATE, PH_L3_OUT, PH_L3_UP, PH_L3_DOWN,
       PH_FIN, PH_COUNT };

__global__ void __launch_bounds__(512, 2) fwd_kernel(Args args) {
    extern __shared__ __attribute__((aligned(16))) unsigned char lds_raw[];
    Ctx F; F.lds = (LAS unsigned char*)lds_raw; F.a = &args;
    volatile LAS unsigned* bst = (volatile LAS unsigned*)(F.lds + 140032);
    if (threadIdx.x < 4) bst[threadIdx.x] = 0u;
    __syncthreads();
    XcdBarrier xbar = xcd_barrier_post((unsigned*)(args.ws + WS_BAR), bst);
    if (threadIdx.x == 0) (void)__hip_atomic_fetch_or((unsigned*)(args.ws + WS_BAR) + 64, 1u << ((xbar.x - blockIdx.x) & 7u), __ATOMIC_RELAXED, __HIP_MEMORY_SCOPE_AGENT);
    constexpr unsigned LOCAL_SEAMS = (1u << PH_L0_SOUT) | (1u << PH_L0_GATE) | (1u << PH_L0_OUT) | (1u << PH_L0_UP) | (1u << PH_L0_DOWN) | (1u << PH_L1_VT) | (1u << PH_L1_ATT) | (1u << PH_L1_WO) | (1u << PH_L1_UP)
                                   | (1u << PH_L2_UP) | (1u << PH_L2_DOWN) | (1u << PH_L3_SOUT) | (1u << PH_L3_GATE) | (1u << PH_L3_OUT) | (1u << PH_L3_UP) | (1u << PH_L3_DOWN);
#pragma nounroll
    for (int ph = args.ph_lo; ph < args.ph_hi; ++ph) {
        { int tid = threadIdx.x; asm volatile("" : "+v"(tid)); F.tid = tid; F.lane = tid & 63; F.wave = __builtin_amdgcn_readfirstlane(tid >> 6);
          int bid = blockIdx.x, G = gridDim.x; asm volatile("" : "+v"(bid), "+v"(G)); F.bid = __builtin_amdgcn_readfirstlane(bid); F.G = __builtin_amdgcn_readfirstlane(G); }
        unsigned char* ws; { int lo = (int)(unsigned)(uintptr_t)args.ws, hi = (int)(unsigned)((uintptr_t)args.ws >> 32); asm volatile("" : "+v"(lo), "+v"(hi));
          ws = (unsigned char*)(((uintptr_t)(unsigned)__builtin_amdgcn_readfirstlane(hi) << 32) | (uintptr_t)(unsigned)__builtin_amdgcn_readfirstlane(lo)); }
        float* stats = (float*)(ws + WS_STATS); bf16_t* xb = (bf16_t*)(ws + WS_XB); unsigned char* R = ws + WS_R;
        int layer = -1, sub = -1;
        if (ph >= PH_L0_U && ph <= PH_L0_DOWN) { layer = 0; const int k = ph - PH_L0_U; sub = k == 0 ? 0 : k == 1 ? 12 : k == 2 ? 14 : k - 1; }
        else if (ph >= PH_L1_QKV && ph <= PH_L1_DOWN) { layer = 1; const int k = ph - PH_L1_QKV; sub = k == 0 ? 6 : k == 1 ? 11 : k == 2 ? 7 : k == 3 ? 8 : k == 4 ? 4 : 5; }
        else if (ph >= PH_L2_PREP && ph <= PH_L2_DOWN) { layer = 2; const int k = ph - PH_L2_PREP; sub = k == 0 ? 9 : k == 1 ? 10 : k == 2 ? 4 : 5; }
        else if (ph >= PH_L3_U && ph <= PH_L3_DOWN) { layer = 3; const int k = ph - PH_L3_U; sub = k == 0 ? 0 : k == 1 ? 12 : k == 2 ? 14 : k - 1; }
        const int j = layer == 3 ? 1 : 0;
        const float* ss_mix = stats;
        const float* ss_mlp = stats + (size_t)16 * T;
        float* ss_next = stats;

        if (ph == PH_PRO) { if (EN(20)) prologue(F); }
        else if (ph == PH_FIN) { if (EN(21)) final_norm(F, args.out, xb, stats, args.in[I_NFIN]); }
        else if (sub == 0 && EN(0)) {
            pg8::Order S; S.init_std(T, D, F.G, F.bid);
            pg8::EpiScaleBf16<0, 1> E{(bf16_t*)R, (size_t)D, ss_mix};
            pg8::gemm_phase(F.tid, F.lds, pg8::mk_opnd(xb, D), pg8::mk_opnd(ws + WS_WIN + (size_t)j * 2 * MiB, D), D, S, E);
        } else if (sub == 12 && EN(12)) {
            pg8::EpiScan E{(bf16_t*)(R + 64 * MiB), (const f32x4*)(ws + WS_APW) + j * 4096};
#pragma nounroll
            for (int L = F.bid; L < 256; L += F.G) {
                pg8::Order S; S.init_grp(256, 4, 0, 0, 1 << 20, L);
                pg8::gemm_phase(F.tid, F.lds, pg8::mk_opnd(R, 512), pg8::mk_opnd(ws + WS_WST + (size_t)j * 16 * MiB, 512), 512, S, E); }
        } else if (sub == 14 && EN(14)) {
            pg8::Order S; S.init_grp(512, 8, 0, 0, F.G, F.bid);
            pg8::Opnd oa = pg8::mk_opnd(R, 256); oa.base2 = (const char*)(R + 64 * MiB);
            pg8::EpiSsmOut E{(const bf16_t*)R, (bf16_t*)(R + 192 * MiB), args.in[I_S5D] + j * D};
            pg8::gemm_phase<pg8::EpiSsmOut, 128, 4>(F.tid, F.lds, oa, pg8::mk_opnd(ws + WS_WSO + (size_t)j * 12 * MiB, 384), 384, S, E);
        } else if (sub == 2 && EN(2)) {
            pg8::Order S; S.init_std(T, D, F.G, F.bid);
            pg8::Opnd oa; oa.base = (const char*)(R + 192 * MiB); oa.base2 = oa.base; oa.tstep = 8192; oa.hstep = 4096; oa.rowB = 32; oa.c16B = (unsigned)T * 32u;
            pg8::EpiGate<1> E{(const bf16_t*)(R + 192 * MiB), (bf16_t*)R};
            pg8::gemm_phase<pg8::EpiGate<1>, (size_t)4 * T * 32>(F.tid, F.lds, oa, pg8::mk_opnd(ws + WS_WGATE + (size_t)j * 2 * MiB, D), D, S, E);
        } else if ((sub == 3 || sub == 8 || sub == 5 || sub == 10) && EN(3)) {
            pg8::Order S; if (sub == 10) S.init_grp(512, 128, 128, 1, F.G, F.bid); else S.init_std(T, D, F.G, F.bid);
            const unsigned char* Aop = sub == 8 ? R + 192 * MiB : R;
            const unsigned char* Bop = sub == 3 ? ws + WS_WOUT + (size_t)j * 2 * MiB : sub == 8 ? ws + WS_WO : sub == 10 ? ws + WS_WPOOL : ws + WS_W2 + (size_t)layer * 8 * MiB;
            const int K = sub == 5 ? FF : sub == 10 ? 256 : D;
            pg8::EpiRes E{xb, sub == 5 ? ss_next : (float*)ss_mlp};
            pg8::gemm_phase(F.tid, F.lds, pg8::mk_opnd(Aop, K), pg8::mk_opnd(Bop, K), K, S, E);
        } else if (sub == 4 && EN(4)) {
            pg8::Order S; S.init_std(T, FF, F.G, F.bid);
            pg8::EpiScaleBf16<1, 0> E{(bf16_t*)R, (size_t)FF, ss_mlp};
            pg8::gemm_phase(F.tid, F.lds, pg8::mk_opnd(xb, D), pg8::mk_opnd(ws + WS_W1 + (size_t)layer * 8 * MiB, D), D, S, E);
        } else if (sub == 6 && EN(6)) {
            pg8::Order S; S.init_std(T, 2 * D, F.G, F.bid);
            pg8::EpiQK E{(bf16_t*)R, (bf16_t*)(R + 64 * MiB), ss_mix, (const float*)(ws + WS_ROPE), (const float*)(ws + WS_ROPE) + SEQ * 32, QSCALE};
            pg8::gemm_phase(F.tid, F.lds, pg8::mk_opnd(xb, D), pg8::mk_opnd(ws + WS_WQK, D), D, S, E);
        } else if (sub == 11 && EN(11)) {
            pg8::Order S; S.init_std(D, T, F.G, F.bid);
            pg8::EpiVT E{(bf16_t*)(R + 128 * MiB), ss_mix, F.lds + 131072};
            pg8::gemm_phase(F.tid, F.lds, pg8::mk_opnd(ws + WS_WV, D), pg8::mk_opnd(xb, D), D, S, E);
        } else if (sub == 7 && EN(7)) {
#ifndef NO_ATT
            att::phase(F, (const bf16_t*)R, (const bf16_t*)(R + 64 * MiB), (const bf16_t*)(R + 128 * MiB), (bf16_t*)(R + 192 * MiB), ((const float*)(ws + WS_MISC))[0]);
#endif
        } else if (sub == 9 && EN(9)) {
            pool_prep(F, xb, ss_mix, (bf16_t*)R);
        }
        if (ph + 1 < args.ph_hi && ph != PH_L1_QKV) {
            if (args.ph_hi > 4096) cg::this_grid().sync();
            const unsigned fl = (unsigned)__builtin_amdgcn_readfirstlane((int)bst[2]);
            xcd_barrier2(xbar, fl == 1u && ((LOCAL_SEAMS >> ph) & 1u));
        }
    }
}

extern "C" void kernel_launch(void* const* d_in, const int* in_sizes, int n_in, void* d_out, int out_size, void* d_ws, size_t ws_size, hipStream_t stream) {
    static int grid = 0;
    if (grid == 0) {
        if (n_in != 26 || out_size != T * D || ws_size < WS_END) { fprintf(stderr, "kernel_launch: unexpected problem (n_in %d out %d ws %zu)\n", n_in, out_size, ws_size); grid = -1; return; }
        int dev = 0, cus = 0, per_cu = 0;
        (void)hipGetDevice(&dev); (void)hipDeviceGetAttribute(&cus, hipDeviceAttributeMultiprocessorCount, dev);
        (void)hipFuncSetAttribute((const void*)fwd_kernel, hipFuncAttributeMaxDynamicSharedMemorySize, LDS_BYTES);
        (void)hipOccupancyMaxActiveBlocksPerMultiprocessor(&per_cu, (const void*)fwd_kernel, 512, LDS_BYTES);
        if (per_cu < 1) { fprintf(stderr, "kernel_launch: occupancy query says %d blocks per CU\n", per_cu); per_cu = 1; }
        (void)hipGetLastError();
        grid = cus * 1;
    }
    if (grid < 0) return;
    Args a{};
    for (int i = 0; i < 26; ++i) a.in[i] = (const float*)d_in[i];
    a.out = (float*)d_out; a.ws = (unsigned char*)d_ws;
    (void)hipMemsetAsync((unsigned char*)d_ws + WS_BAR, 0, XCD_BAR_WORDS * 4, stream);
    a.ph_lo = 0; a.ph_hi = PH_COUNT;
    void* kargs[] = {&a};
    hipError_t e = hipLaunchCooperativeKernel((const void*)fwd_kernel, dim3(grid), dim3(512), kargs, LDS_BYTES, stream);
    if (e != hipSuccess) fprintf(stderr, "cooperative launch failed: %s (grid %d)\n", hipGetErrorString(e), grid);
}
```
